# Optimizing an MI355X kernel written in HIP

```python
import math
import jax, jax.numpy as jnp
from jax import lax
import numpy as np

D_MODEL = 4096
BATCH = 4
SEQ = 2048
DEPTH = 1
DEC_BATCH = 128
DEC_SEQ = 4
PAST_LEN = 16384
PAGE_SIZE = 128

SSD_HEADS = 64
SSD_HEAD_DIM = 64
D_SSD = SSD_HEADS * SSD_HEAD_DIM
SSD_GROUPS = 8
SSD_STATE = 128
SSD_CONV = 4
SSD_CHUNK = 128
CONV_DIM = D_SSD + 2 * SSD_GROUPS * SSD_STATE
DT_MIN = 1e-3
DT_MAX = 1e-1
SG_CHUNK = 128
SG_GROUPS = 8
D_SG = 2048
SG_HEAD_DIM = D_SG // SG_GROUPS
IN_SPLITS = (D_SSD,
             D_SSD + CONV_DIM,
             D_SSD + CONV_DIM + SSD_HEADS,
             D_SSD + CONV_DIM + SSD_HEADS + D_SG,
             D_SSD + CONV_DIM + SSD_HEADS + 2 * D_SG,
             D_SSD + CONV_DIM + SSD_HEADS + 2 * D_SG + D_MODEL)
D_IN = D_SSD + CONV_DIM + SSD_HEADS + 2 * D_SG + 2 * D_MODEL
N_GROUPS = 8
EXPERTS_PER_GROUP = 4
N_EXPERTS = N_GROUPS * EXPERTS_PER_GROUP
D_EXPERT = 512
TOP_K = 2
ALPHA = (2 * DEPTH) ** 0.25
BETA = (8 * DEPTH) ** -0.25
LN_EPS = 1e-5
RMS_EPS = 1e-5

kernel_name = 'hybrid_ssd_sgu_hmoe_deepnorm_step'


def layer_norm(x, g, b):
    xf = x.astype(jnp.float32)
    mu = jnp.mean(xf, -1, keepdims=True)
    var = jnp.mean(jnp.square(xf - mu), -1, keepdims=True)
    return ((xf - mu) * lax.rsqrt(var + LN_EPS)).astype(x.dtype) * g + b


def grouped_rms_norm(y, g):
    b, l, d = y.shape
    yf = y.astype(jnp.float32).reshape(b, l, SSD_GROUPS, d // SSD_GROUPS)
    yf = yf * lax.rsqrt(jnp.mean(yf * yf, -1, keepdims=True) + RMS_EPS)
    return yf.reshape(b, l, d).astype(y.dtype) * g


def causal_conv(xbc, buf, w, bias):
    l = xbc.shape[1]
    xp = jnp.concatenate([buf.astype(xbc.dtype), xbc], axis=1)
    y = bias
    for k in range(SSD_CONV):
        y = y + w[k] * xp[:, k:k + l]
    return y, xp[:, -(SSD_CONV - 1):]


def ssd_chunked(x, dt, a, bm, cm, s0):
    f32 = jnp.float32
    b, l = x.shape[:2]
    q = min(SSD_CHUNK, l)
    pad = (-l) % q
    x, dt, bm, cm = (jnp.pad(t.astype(f32), [(0, 0), (0, pad)] + [(0, 0)] * (t.ndim - 2))
                     for t in (x, dt, bm, cm))
    nc = (l + pad) // q
    hpg = SSD_HEADS // SSD_GROUPS
    x = x.reshape(b, nc, q, SSD_GROUPS, hpg, SSD_HEAD_DIM)
    dt = dt.reshape(b, nc, q, SSD_GROUPS, hpg)
    bm = bm.reshape(b, nc, q, SSD_GROUPS, SSD_STATE)
    cm = cm.reshape(b, nc, q, SSD_GROUPS, SSD_STATE)
    a_cs = jnp.cumsum(dt * a.reshape(SSD_GROUPS, hpg), axis=2)
    causal = jnp.tril(jnp.ones((q, q), dtype=bool))[:, :, None, None]
    seg = a_cs[:, :, :, None] - a_cs[:, :, None, :]
    decay = jnp.exp(jnp.where(causal, seg, -jnp.inf))
    scores = jnp.einsum('bcign,bcjgn->bcijg', cm, bm)
    y_diag = jnp.einsum('bcijgk,bcjgkp->bcigkp', scores[..., None] * decay * dt[:, :, None], x)
    to_end = jnp.exp(a_cs[:, :, -1:] - a_cs) * dt
    states = jnp.einsum('bcjgn,bcjgkp->bcgkpn', bm, x * to_end[..., None])
    chunk_decay = jnp.exp(a_cs[:, :, -1])

    def step(s, inp):
        st, dc = inp
        return s * dc[..., None, None] + st, s

    s0 = s0.astype(f32).reshape(b, SSD_GROUPS, hpg, SSD_HEAD_DIM, SSD_STATE)
    s_fin, s_prev = lax.scan(step, s0, (jnp.moveaxis(states, 1, 0), jnp.moveaxis(chunk_decay, 1, 0)))
    s_prev = jnp.moveaxis(s_prev, 0, 1)
    y_off = jnp.einsum('bcign,bcgkpn->bcigkp', cm, s_prev) * jnp.exp(a_cs)[..., None]
    y = (y_diag + y_off).reshape(b, nc * q, SSD_HEADS, SSD_HEAD_DIM)[:, :l]
    return y, s_fin.reshape(b, SSD_HEADS, SSD_HEAD_DIM, SSD_STATE)


def spatial_gating(u, v, sg_w, sg_b):
    b, l = u.shape[:2]
    pad = (-l) % SG_CHUNK
    nc = (l + pad) // SG_CHUNK
    vp = jnp.pad(v, ((0, 0), (0, pad), (0, 0))).reshape(b, nc, SG_CHUNK, SG_GROUPS, SG_HEAD_DIM)
    mixed = jnp.einsum('gij,bcjgd->bcigd', jnp.tril(sg_w), vp) + sg_b.T[:, :, None]
    return u * mixed.reshape(b, nc * SG_CHUNK, D_SG)[:, :l]


def gated_mixer(x, conv_buf, ssm_state, p):
    b, l, _ = x.shape
    h = jnp.einsum('bld,de->ble', x, p['w_in'])
    z, xbc, dt_raw, u, v, gate_ssd, gate_sg = jnp.split(h, IN_SPLITS, axis=-1)
    xbc, new_buf = causal_conv(xbc, conv_buf, p['conv_w'], p['conv_b'])
    xbc = jax.nn.silu(xbc)
    xs, bm, cm = jnp.split(xbc, [D_SSD, D_SSD + SSD_GROUPS * SSD_STATE], axis=-1)
    xs = xs.reshape(b, l, SSD_HEADS, SSD_HEAD_DIM)
    dt = jax.nn.softplus(dt_raw.astype(jnp.float32) + p['dt_bias'].astype(jnp.float32))
    a = -jnp.exp(p['a_log'].astype(jnp.float32))
    y, new_state = ssd_chunked(xs, dt, a, bm.reshape(b, l, SSD_GROUPS, SSD_STATE),
                               cm.reshape(b, l, SSD_GROUPS, SSD_STATE), ssm_state)
    y = y.astype(x.dtype) + p['d_skip'][:, None] * xs
    y_ssd = grouped_rms_norm(y.reshape(b, l, D_SSD) * jax.nn.silu(z), p['ssd_norm_g'])
    u = jax.nn.gelu(u)
    v = layer_norm(jax.nn.gelu(v), p['sg_ln_g'], p['sg_ln_b'])
    y_sg = spatial_gating(u, v, p['sg_w'], p['sg_b'])
    merged = (jax.nn.sigmoid(gate_ssd) * jnp.einsum('ble,ed->bld', y_ssd, p['p_ssd'])
              + jax.nn.sigmoid(gate_sg) * jnp.einsum('ble,ed->bld', y_sg, p['p_sg']))
    out = jnp.einsum('bld,de->ble', merged, p['w_out'])
    return out, new_buf, new_state.astype(ssm_state.dtype), v


def hier_moe(x, p):
    b, l, d = x.shape
    xf = x.reshape(b * l, d)
    t = xf.shape[0]
    g_logits = jnp.einsum('td,dg->tg', xf, p['w_router_group']).astype(jnp.float32) + p['b_router_group']
    grp = jnp.argmax(g_logits, -1)
    p_grp = jnp.take_along_axis(jax.nn.softmax(g_logits, -1), grp[:, None], -1)
    e_logits = (jnp.einsum('td,de->te', xf, p['w_router_expert']).astype(jnp.float32)
                + p['b_router_expert']).reshape(t, N_GROUPS, EXPERTS_PER_GROUP)
    e_in = jnp.take_along_axis(e_logits, grp[:, None, None], 1)[:, 0]
    top_v, top_i = lax.top_k(e_in, TOP_K)
    top_w = jax.nn.softmax(top_v, -1) * p_grp
    expert_id = grp[:, None] * EXPERTS_PER_GROUP + top_i
    gates = jnp.sum(jax.nn.one_hot(expert_id, N_EXPERTS, dtype=jnp.float32) * top_w[..., None], axis=1)
    gates = gates.astype(x.dtype)
    y = jnp.zeros_like(xf)
    for g in range(N_GROUPS):
        sl = slice(g * EXPERTS_PER_GROUP, (g + 1) * EXPERTS_PER_GROUP)
        hg = jnp.einsum('td,edf->tef', xf, p['w_gate'][sl])
        hu = jnp.einsum('td,edf->tef', xf, p['w_up'][sl])
        hh = jax.nn.silu(hg) * hu * gates[:, sl, None]
        y = y + jnp.einsum('tef,efd->td', hh, p['w_down'][sl])
    return y.reshape(b, l, d)


def decoder_layer(x, conv_buf, ssm_state, p):
    m, new_buf, new_state, v = gated_mixer(x, conv_buf, ssm_state, p)
    x = layer_norm(ALPHA * x + m, p['ln1_g'], p['ln1_b'])
    x = layer_norm(ALPHA * x + hier_moe(x, p), p['ln2_g'], p['ln2_b'])
    return x, new_buf, new_state, v


def setup_inputs(seed: int = 0) -> dict:
    key = jax.random.key(seed)
    ks = jax.random.split(key, 32)
    f32 = jnp.float32
    L = DEPTH

    def nrm(i, shape, scale):
        return jax.random.normal(ks[i], shape, f32) * scale

    dt0 = jnp.exp(jax.random.uniform(ks[0], (L, SSD_HEADS), f32, math.log(DT_MIN), math.log(DT_MAX)))
    return {
        'x_prompt': nrm(1, (BATCH, SEQ, D_MODEL), 1.0),
        'x_sample': nrm(2, (DEC_BATCH, DEC_SEQ, D_MODEL), 1.0),
        'state_ssd': nrm(3, (L, DEC_BATCH, SSD_HEADS, SSD_HEAD_DIM, SSD_STATE), 0.1),
        'state_ssd_conv': nrm(4, (L, DEC_BATCH, SSD_CONV - 1, CONV_DIM), 1.0),
        'w_in': nrm(5, (L, D_MODEL, D_IN), D_MODEL ** -0.5),
        'conv_w': nrm(6, (L, SSD_CONV, CONV_DIM), SSD_CONV ** -0.5),
        'conv_b': nrm(7, (L, CONV_DIM), 0.02),
        'dt_bias': dt0 + jnp.log(-jnp.expm1(-dt0)),
        'a_log': jnp.log(jax.random.uniform(ks[8], (L, SSD_HEADS), f32, 1.0, 16.0)),
        'd_skip': 1.0 + nrm(9, (L, SSD_HEADS), 0.1),
        'ssd_norm_g': 1.0 + nrm(10, (L, D_SSD), 0.02),
        'sg_ln_g': 1.0 + nrm(11, (L, D_SG), 0.02),
        'sg_ln_b': nrm(12, (L, D_SG), 0.02),
        'sg_w': nrm(13, (L, SG_GROUPS, SG_CHUNK, SG_CHUNK), SG_CHUNK ** -0.5),
        'sg_b': 1.0 + nrm(14, (L, SG_GROUPS, SG_CHUNK), 0.02),
        'p_ssd': nrm(15, (L, D_SSD, D_MODEL), BETA * D_SSD ** -0.5),
        'p_sg': nrm(16, (L, D_SG, D_MODEL), BETA * D_SG ** -0.5),
        'w_out': nrm(17, (L, D_MODEL, D_MODEL), BETA * D_MODEL ** -0.5),
        'ln1_g': 1.0 + nrm(18, (L, D_MODEL), 0.02),
        'ln1_b': nrm(19, (L, D_MODEL), 0.02),
        'w_router_group': nrm(20, (L, D_MODEL, N_GROUPS), D_MODEL ** -0.5),
        'b_router_group': nrm(21, (L, N_GROUPS), 0.01),
        'w_router_expert': nrm(22, (L, D_MODEL, N_EXPERTS), D_MODEL ** -0.5),
        'b_router_expert': nrm(23, (L, N_EXPERTS), 0.01),
        'w_gate': nrm(24, (L, N_EXPERTS, D_MODEL, D_EXPERT), BETA * D_MODEL ** -0.5),
        'w_up': nrm(25, (L, N_EXPERTS, D_MODEL, D_EXPERT), BETA * D_MODEL ** -0.5),
        'w_down': nrm(26, (L, N_EXPERTS, D_EXPERT, D_MODEL), BETA * D_EXPERT ** -0.5),
        'ln2_g': 1.0 + nrm(27, (L, D_MODEL), 0.02),
        'ln2_b': nrm(28, (L, D_MODEL), 0.02),
    }


def reference(x_prompt, x_sample, state_ssd, state_ssd_conv, w_in, conv_w, conv_b, dt_bias, a_log,
              d_skip, ssd_norm_g, sg_ln_g, sg_ln_b, sg_w, sg_b, p_ssd, p_sg, w_out, ln1_g, ln1_b,
              w_router_group, b_router_group, w_router_expert, b_router_expert, w_gate, w_up, w_down,
              ln2_g, ln2_b):
    st_p, buf_p, st_s, buf_s, v_s = [], [], [], [], []
    for l in range(DEPTH):
        p = dict(w_in=w_in[l], conv_w=conv_w[l], conv_b=conv_b[l], dt_bias=dt_bias[l], a_log=a_log[l],
                 d_skip=d_skip[l], ssd_norm_g=ssd_norm_g[l], sg_ln_g=sg_ln_g[l], sg_ln_b=sg_ln_b[l],
                 sg_w=sg_w[l], sg_b=sg_b[l], p_ssd=p_ssd[l], p_sg=p_sg[l], w_out=w_out[l],
                 ln1_g=ln1_g[l], ln1_b=ln1_b[l], w_router_group=w_router_group[l],
                 b_router_group=b_router_group[l], w_router_expert=w_router_expert[l],
                 b_router_expert=b_router_expert[l], w_gate=w_gate[l], w_up=w_up[l], w_down=w_down[l],
                 ln2_g=ln2_g[l], ln2_b=ln2_b[l])
        bp = x_prompt.shape[0]
        zero_buf = jnp.zeros((bp, SSD_CONV - 1, CONV_DIM), x_prompt.dtype)
        zero_state = jnp.zeros((bp, SSD_HEADS, SSD_HEAD_DIM, SSD_STATE), x_prompt.dtype)
        x_prompt, nb_p, ns_p, _ = decoder_layer(x_prompt, zero_buf, zero_state, p)
        x_sample, nb_s, ns_s, nv_s = decoder_layer(x_sample, state_ssd_conv[l], state_ssd[l], p)
        st_p.append(ns_p)
        buf_p.append(nb_p)
        st_s.append(ns_s)
        buf_s.append(nb_s)
        v_s.append(nv_s)
    ssd_state_prompt = jnp.stack(st_p)
    ssd_conv_prompt = jnp.stack(buf_p)
    ssd_state_sample = jnp.stack(st_s)
    ssd_conv_sample = jnp.stack(buf_s)
    sgu_v_sample = jnp.stack(v_s)
    return (x_prompt, x_sample, ssd_state_prompt, ssd_conv_prompt, ssd_state_sample, ssd_conv_sample, sgu_v_sample)
```

```cpp
#include <hip/hip_runtime.h>
#include <cstdio>
#include <cstdint>
namespace pg8 {
#define PG8_LAS __attribute__((address_space(3)))
typedef unsigned short bf16_t;
typedef short bf16x8 __attribute__((ext_vector_type(8)));
typedef float f32x4 __attribute__((ext_vector_type(4)));
typedef unsigned u32x4 __attribute__((ext_vector_type(4)));
typedef unsigned u32x2_f8 __attribute__((ext_vector_type(2)));
constexpr int BM = 256, BK = 64, HALF = 128, HTB = HALF * BK * 2  , STAGE_BYTES = 8 * HTB, NXCD = 8, WGM = 8;

__host__ __device__ __forceinline__ int lds_byte(int r, int c) { const int st = (r >> 4) * 2 + (c >> 5), rr = r & 15, cc = c & 31, ob = rr * 64 + cc * 2; return st * 1024 + (ob ^ (((ob >> 9) & 1) << 5)); }
__host__ __device__ __forceinline__ void stage_rc(int b, int& R, int& C) { const int st = b / 1024, sb = b % 1024, swz = sb ^ (((sb >> 9) & 1) << 5); R = (st >> 1) * 16 + swz / 64; C = (st & 1) * 32 + (swz % 64) / 2; }
__host__ __device__ __forceinline__ int perm32(int rho) { const int n = rho >> 4, i = rho & 15; return 8 * (i >> 2) + 4 * n + (i & 3); }

struct Unit { int pm, pn; };
struct Gemm { const bf16_t* A; const bf16_t* Bt; int M, N, K; const unsigned* sA = nullptr; const unsigned* sB = nullptr; };

struct StaticOrder {
    int nM, nN, nwg, G, c;
    __host__ __device__ void init(int M, int N, int G_, int c_) { nM = M / BM; nN = N / BM; nwg = nM * nN; G = G_; c = c_; }
    __host__ __device__ bool next(int i, Unit& u) const { return at((long)i * G + c, u); }
    __host__ __device__ bool at(long L, Unit& u) const {
        if (L >= nwg) return false;
        int wgid = (int)L; { const int q = nwg / NXCD, r = nwg % NXCD, xcd = wgid % NXCD, off = wgid / NXCD; wgid = (xcd < r ? xcd * (q + 1) : r * (q + 1) + (xcd - r) * q) + off; }
        const int nig = WGM * nN, gid = wgid / nig, fm = gid * WGM, gsz = (nM - fm) < WGM ? (nM - fm) : WGM;
        u.pm = fm + ((wgid % nig) % gsz); u.pn = (wgid % nig) / gsz; return true;
    }
    __device__ __forceinline__ void a_ready(const Unit&) const {}
    __device__ __forceinline__ void done(const Unit&) const {}
};

struct SelOrder {
    int kind, c;
    __host__ __device__ void init(int, int, int c_, int kind_) { kind = kind_; c = c_; }
    __host__ __device__ bool next(int i, Unit& u) const {
        const int x = c & 7, lc = c >> 3; const bool big = x < 2;
        const int sz0 = big ? 8 : 6, sz1 = big ? 21 : 18, sz2 = big ? 3 : 8;
        const int cn0 = kind ? 0 : 8, cn1 = kind ? 11 : 2, cn2 = kind ? (big ? 13 : 9) : (big ? 1 : 3);
        const int cls = lc < sz0 ? 0 : (lc < sz0 + sz1 ? 1 : 2), lin = lc - (cls == 0 ? 0 : (cls == 1 ? sz0 : sz0 + sz1)), mycn = cls == 0 ? cn0 : (cls == 1 ? cn1 : cn2);
        if (i >= mycn) return false;
        int s = lin + sz0 * (cn0 < i ? cn0 : i) + sz1 * (cn1 < i ? cn1 : i) + sz2 * (cn2 < i ? cn2 : i);
        if (cls > 0 && cn0 > i) s += sz0;
        if (cls > 1 && cn1 > i) s += sz1;
        StaticOrder S; S.init(34 * BM, (kind ? 56 : 25) * BM, 256, c);
        const int nrx = S.nwg / NXCD + (x < S.nwg % NXCD ? 1 : 0), nex = kind ? 32 : 2;
        if (s < nrx) { S.at((long)s * NXCD + x, u); const int j = u.pn; u.pn = kind ? (j < 16 ? j : (j < 24 ? j + 24 : j + 32)) : (j < 24 ? j + 16 : 88); return true; }
        const int e = nex * x + (s - nrx);
        u.pm = kind ? (e >> 3) : 32 + (e >> 3); u.pn = 48 + (e & 7); return true;
    }
    __device__ __forceinline__ void a_ready(const Unit&) const {}
    __device__ __forceinline__ void done(const Unit&) const {}
};
typedef float f32x2_cv __attribute__((ext_vector_type(2))); typedef __bf16 bf16x2_cv __attribute__((ext_vector_type(2)));
__device__ __forceinline__ unsigned cvt_pk_bf16(float lo, float hi) { const f32x2_cv v = {lo, hi}; const bf16x2_cv b = __builtin_convertvector(v, bf16x2_cv); return __builtin_bit_cast(unsigned, b); }
__device__ __forceinline__ int e8m0_of(float am) { const int eb = (int)((__builtin_bit_cast(unsigned, am) >> 23) & 0xffu) - 7; return eb < 1 ? 1 : eb; }
__device__ __forceinline__ float e8m0_inv(int byte) { return __builtin_bit_cast(float, (unsigned)(254 - byte) << 23); }
__device__ __forceinline__ unsigned pk4_fp8(float a, float b, float c, float d) { int w = __builtin_amdgcn_cvt_pk_fp8_f32(a, b, 0, false); w = __builtin_amdgcn_cvt_pk_fp8_f32(c, d, w, true); return (unsigned)w; }
constexpr int T_ROWS = 8704, T_PROMPT = 8192, LDH = 22784;
constexpr int C_Z = 0, C_XBC = 4096, C_U = 10240, C_V = 12288, C_G1 = 14336, C_G2 = 18432, C_DT = 22528;
constexpr float ALPHA_DN = 1.189207115002721f;

__device__ __forceinline__ float sigm(float a) { return __builtin_amdgcn_rcpf(1.0f + __builtin_amdgcn_exp2f(-1.4426950408889634f * a)); }
__device__ __forceinline__ float bflo(unsigned w) { return __builtin_bit_cast(float, w << 16); }
__device__ __forceinline__ float bfhi(unsigned w) { return __builtin_bit_cast(float, w & 0xffff0000u); }

struct EpiIn {
    static constexpr bool PERM = true, AFTER_DRAIN = false, MIDK = false;
    bf16_t* H; float* dtb; const float* dt_bias; unsigned char* G8;
    __device__ __forceinline__ void operator()(const f32x4 (&acc)[2][2][4][2], const Unit& u, int wr, int wc, int fr, int fq) const {
        const int pn = u.pn, row0 = u.pm * BM + wr * 64 + fr;
        if (pn >= 88) {
            if (wc < 2) {
                const int c0 = wc * 32 + 8 * fq;
                const f32x4 b0 = *(const f32x4*)(dt_bias + c0), b1 = *(const f32x4*)(dt_bias + c0 + 4);
#pragma unroll
                for (int ai = 0; ai < 2; ++ai)
#pragma unroll
                    for (int m = 0; m < 4; ++m) {
                        f32x4 v0 = acc[ai][0][m][0] + b0, v1 = acc[ai][0][m][1] + b1;
#pragma unroll
                        for (int j = 0; j < 4; ++j) { v0[j] = v0[j] > 20.f ? v0[j] : log1pf(expf(v0[j])); v1[j] = v1[j] > 20.f ? v1[j] : log1pf(expf(v1[j])); }
                        float* o = dtb + (size_t)(row0 + ai * HALF + m * 16) * 64 + c0;
                        *(f32x4*)o = v0; *(f32x4*)(o + 4) = v1;
                    }
            }
            return;
        }
        if (pn >= 56) {
            unsigned char* gp = G8 + (size_t)row0 * 8192 + (size_t)((pn - 56) >> 4) * 4096 + ((pn - 56) & 15) * 256 + (wc * 4 + fq) * 16;
#pragma unroll
            for (int ai = 0; ai < 2; ++ai)
#pragma unroll
                for (int m = 0; m < 4; ++m) { u32x4 w;
#pragma unroll
                    for (int bj = 0; bj < 2; ++bj)
#pragma unroll
                        for (int n = 0; n < 2; ++n) { unsigned d = 0u;
#pragma unroll
                            for (int j = 0; j < 4; ++j) d = __builtin_amdgcn_cvt_pk_u8_f32(fmaxf(sigm(acc[ai][bj][m][n][j]) * 255.0f, 1.0f), j, d);
                            w[bj * 2 + n] = d; }
                    *(u32x4*)(gp + (size_t)(ai * HALF + m * 16) * 8192) = w; }
            return;
        }
        const int mode = pn < 16 ? 1 : (pn < 40 ? 0 : 2);
        const int col0 = pn * BM + wc * 32 + 8 * fq;
#define EPIIN_BODY(ACT) do { _Pragma("unroll") for (int ai = 0; ai < 2; ++ai) _Pragma("unroll") for (int m = 0; m < 4; ++m) { bf16_t* rowp = H + (size_t)(row0 + ai * HALF + m * 16) * LDH + col0; \
            _Pragma("unroll") for (int bj = 0; bj < 2; ++bj) { f32x4 v0 = acc[ai][bj][m][0], v1 = acc[ai][bj][m][1]; \
                _Pragma("unroll") for (int j = 0; j < 4; ++j) { const float x0 = v0[j], x1 = v1[j]; v0[j] = ACT(x0); v1[j] = ACT(x1); } \
                u32x4 w; w.x = cvt_pk_bf16(v0[0], v0[1]); w.y = cvt_pk_bf16(v0[2], v0[3]); w.z = cvt_pk_bf16(v1[0], v1[1]); w.w = cvt_pk_bf16(v1[2], v1[3]); \
                *(u32x4*)(rowp + bj * HALF) = w; } } } while (0)
#define ACT_ID(x) (x)
#define ACT_SILU(x) ((x) * sigm(x))
#define ACT_GELU(x) ((x) * sigm((x) * (1.5957691216057308f + 0.07135481627260025f * (x) * (x))))
#define ACT_SIGM(x) sigm(x)
        if (mode == 0) EPIIN_BODY(ACT_ID); else if (mode == 1) EPIIN_BODY(ACT_SILU); else EPIIN_BODY(ACT_GELU);
#undef EPIIN_BODY
#undef ACT_ID
#undef ACT_SILU
#undef ACT_GELU
#undef ACT_SIGM
    }
};

struct EpiMerge {
    static constexpr bool PERM = true, AFTER_DRAIN = false, MIDK = true;
    const unsigned char* G8; unsigned char* O; int tsplit; PG8_LAS float* X; unsigned* SA;
    __device__ __forceinline__ void mid(f32x4 (&acc)[2][2][4][2], const Unit& u, int wr, int wc, int fr, int fq) const {
        unsigned rb = (unsigned)(u.pm * BM + wr * 64 + fr) * 8192u + (unsigned)(u.pn * 256 + (wc * 4 + fq) * 16);
        asm volatile("" : "+v"(rb));
#pragma unroll
        for (int ai = 0; ai < 2; ++ai)
#pragma unroll
            for (int m = 0; m < 4; ++m) { const unsigned ro = rb + (unsigned)((ai * HALF + m * 16) * 8192);
                const u32x4 a = *(const u32x4*)(G8 + ro), b = *(const u32x4*)(G8 + ro + 4096);
#pragma unroll
                for (int bj = 0; bj < 2; ++bj)
#pragma unroll
                    for (int n = 0; n < 2; ++n) { const unsigned qa = a[bj * 2 + n], qb = b[bj * 2 + n]; f32x4 r;
                        r[0] = (float)(qa & 0xffu) * __builtin_amdgcn_rcpf((float)(qb & 0xffu)); r[1] = (float)((qa >> 8) & 0xffu) * __builtin_amdgcn_rcpf((float)((qb >> 8) & 0xffu));
                        r[2] = (float)((qa >> 16) & 0xffu) * __builtin_amdgcn_rcpf((float)((qb >> 16) & 0xffu)); r[3] = (float)(qa >> 24) * __builtin_amdgcn_rcpf((float)(qb >> 24));
                        acc[ai][bj][m][n] *= r; }
                asm volatile("" ::: "memory"); }
    }
    __device__ __forceinline__ void operator()(f32x4 (&acc)[2][2][4][2], const Unit& u, int wr, int wc, int fr, int fq) const {
        unsigned rrow = (unsigned)(u.pm * BM + wr * 64 + fr), cc = (unsigned)(u.pn * BM + wc * 32 + 8 * fq), gg = (unsigned)(u.pn * 256 + (wc * 4 + fq) * 16);
        asm volatile("" : "+v"(rrow), "+v"(cc), "+v"(gg));
        constexpr float K255 = 1.0f / 255.0f; float rmax[8];
#pragma unroll
        for (int ai = 0; ai < 2; ++ai)
#pragma unroll
            for (int m = 0; m < 4; ++m) { const unsigned row = rrow + (unsigned)(ai * HALF + m * 16);
                const u32x4 b = *(const u32x4*)(G8 + row * 8192u + 4096u + gg); float am = 0.f;
#pragma unroll
                for (int bj = 0; bj < 2; ++bj)
#pragma unroll
                    for (int n = 0; n < 2; ++n) { const unsigned q = b[bj * 2 + n];
                        const f32x4 gt = {(float)(q & 0xffu) * K255, (float)((q >> 8) & 0xffu) * K255, (float)((q >> 16) & 0xffu) * K255, (float)(q >> 24) * K255};
                        acc[ai][bj][m][n] *= gt; const f32x4 v = acc[ai][bj][m][n];
                        am = fmaxf(fmaxf(am, fmaxf(fabsf(v[0]), fabsf(v[1]))), fmaxf(fabsf(v[2]), fabsf(v[3]))); }
                am = fmaxf(am, __shfl_xor(am, 16)); am = fmaxf(am, __shfl_xor(am, 32)); rmax[ai * 4 + m] = am;
                asm volatile("" ::: "memory"); }
        const int lr = wr * 64 + (int)(rrow & 15u);
        if (fq == 0) {
#pragma unroll
            for (int i = 0; i < 8; ++i) X[(lr + (i >> 2) * HALF + (i & 3) * 16) * 4 + wc] = rmax[i]; }
        asm volatile("s_waitcnt lgkmcnt(0)" ::: "memory"); __builtin_amdgcn_s_barrier(); asm volatile("" ::: "memory");
        unsigned sw[2] = {0u, 0u};
#pragma unroll
        for (int ai = 0; ai < 2; ++ai)
#pragma unroll
            for (int m = 0; m < 4; ++m) { const unsigned row = rrow + (unsigned)(ai * HALF + m * 16);
                const f32x4 x4 = *(const PG8_LAS f32x4*)(X + (lr + ai * HALF + m * 16) * 4);
                const int sb = e8m0_of(fmaxf(fmaxf(x4[0], x4[1]), fmaxf(x4[2], x4[3]))); const float inv = e8m0_inv(sb); sw[ai] |= (unsigned)sb << (8 * m);
#pragma unroll
                for (int bj = 0; bj < 2; ++bj) { const f32x4 v0 = acc[ai][bj][m][0] * inv, v1 = acc[ai][bj][m][1] * inv;
                    *(u32x2_f8*)(O + (size_t)row * 4096 + cc + bj * HALF) = (u32x2_f8){pk4_fp8(v0[0], v0[1], v0[2], v0[3]), pk4_fp8(v1[0], v1[1], v1[2], v1[3])}; } }
        if (wc == 0 && fq == 0) { unsigned* sp = SA + ((size_t)(u.pm * 16 + u.pn) * 2 + wr) * 32 + (rrow & 15u); sp[0] = sw[0]; sp[16] = sw[1]; }
    }
};

struct EpiRes {
    static constexpr bool PERM = true, AFTER_DRAIN = false, MIDK = false;
    const bf16_t* xb; bf16_t* R;
    __device__ __forceinline__ void operator()(const f32x4 (&acc)[2][2][4][2], const Unit& u, int wr, int wc, int fr, int fq) const {
        const int row0 = u.pm * BM + wr * 64 + fr, col0 = u.pn * BM + wc * 32 + 8 * fq;
#pragma unroll
        for (int ai = 0; ai < 2; ++ai)
#pragma unroll
            for (int m = 0; m < 4; ++m) { const size_t off = (size_t)(row0 + ai * HALF + m * 16) * 4096 + col0;
#pragma unroll
                for (int bj = 0; bj < 2; ++bj) { const u32x4 x = *(const u32x4*)(xb + off + bj * HALF);
                    const f32x4 v0 = (f32x4){bflo(x.x), bfhi(x.x), bflo(x.y), bfhi(x.y)} * ALPHA_DN + acc[ai][bj][m][0], v1 = (f32x4){bflo(x.z), bfhi(x.z), bflo(x.w), bfhi(x.w)} * ALPHA_DN + acc[ai][bj][m][1];
                    u32x4 w; w.x = cvt_pk_bf16(v0[0], v0[1]); w.y = cvt_pk_bf16(v0[2], v0[3]); w.z = cvt_pk_bf16(v1[0], v1[1]); w.w = cvt_pk_bf16(v1[2], v1[3]);
                    *(u32x4*)(R + off + bj * HALF) = w; } }
    }
};

struct EpiGU {
    static constexpr bool PERM = true, AFTER_DRAIN = false, MIDK = false;
    const float* gws; unsigned char* Hm;
    __device__ __forceinline__ void operator()(const f32x4 (&acc)[2][2][4][2], const Unit& u, int wr, int wc, int fr, int fq) const {
        const int pnl = u.pn & 15, el = pnl >> 2, row0 = u.pm * BM + wr * 64 + fr, col0 = pnl * 128 + wc * 32 + 8 * fq;
#pragma unroll
        for (int ai = 0; ai < 2; ++ai)
#pragma unroll
            for (int m = 0; m < 4; ++m) { const size_t row = (size_t)(row0 + ai * HALF + m * 16); const float gw = gws[row * 4 + el];
                f32x4 v0, v1;
#pragma unroll
                for (int j = 0; j < 4; ++j) { const float g0 = acc[ai][0][m][0][j], g1 = acc[ai][0][m][1][j];
                    v0[j] = g0 * sigm(g0) * acc[ai][1][m][0][j] * gw; v1[j] = g1 * sigm(g1) * acc[ai][1][m][1][j] * gw; }
                int w0 = __builtin_amdgcn_cvt_pk_bf8_f32(v0[0], v0[1], 0, false); w0 = __builtin_amdgcn_cvt_pk_bf8_f32(v0[2], v0[3], w0, true);
                int w1 = __builtin_amdgcn_cvt_pk_bf8_f32(v1[0], v1[1], 0, false); w1 = __builtin_amdgcn_cvt_pk_bf8_f32(v1[2], v1[3], w1, true);
                *(u32x2_f8*)(Hm + row * 2048 + col0) = (u32x2_f8){(unsigned)w0, (unsigned)w1}; }
    }
};

struct EpiDown {
    static constexpr bool PERM = true, AFTER_DRAIN = false, MIDK = false;
    const int* tokmap; const bf16_t* x1; bf16_t* R2;
    __device__ __forceinline__ void operator()(const f32x4 (&acc)[2][2][4][2], const Unit& u, int wr, int wc, int fr, int fq) const {
        const int pnl = u.pn & 15, row0 = u.pm * BM + wr * 64 + fr, col0 = pnl * BM + wc * 32 + 8 * fq;
        int tok[8];
#pragma unroll
        for (int i = 0; i < 8; ++i) tok[i] = tokmap[row0 + (i >> 2) * HALF + (i & 3) * 16];
#pragma unroll
        for (int ai = 0; ai < 2; ++ai)
#pragma unroll
            for (int m = 0; m < 4; ++m) { const int tk = tok[ai * 4 + m];
                if (tk >= 0) { const bf16_t* xr = x1 + (size_t)tk * 4096 + col0; bf16_t* rp = R2 + (size_t)tk * 4096 + col0;
                    const u32x4 xa = *(const u32x4*)xr, xb = *(const u32x4*)(xr + HALF);
#pragma unroll
                    for (int bj = 0; bj < 2; ++bj) { const u32x4 x = bj ? xb : xa;
                        const f32x4 v0 = (f32x4){bflo(x.x), bfhi(x.x), bflo(x.y), bfhi(x.y)} * ALPHA_DN + acc[ai][bj][m][0], v1 = (f32x4){bflo(x.z), bfhi(x.z), bflo(x.w), bfhi(x.w)} * ALPHA_DN + acc[ai][bj][m][1];
                        u32x4 w; w.x = cvt_pk_bf16(v0[0], v0[1]); w.y = cvt_pk_bf16(v0[2], v0[3]); w.z = cvt_pk_bf16(v1[0], v1[1]); w.w = cvt_pk_bf16(v1[2], v1[3]);
                        *(u32x4*)(rp + bj * HALF) = w; } } }
    }
};

struct MoeOrder {
    int tb[9]; int G, c;
    __device__ __forceinline__ void init(const unsigned* cnt, int G_, int c_) { G = G_; c = c_; tb[0] = 0;
#pragma unroll
        for (int g = 0; g < 8; ++g) tb[g + 1] = tb[g] + (int)((__builtin_amdgcn_readfirstlane(cnt[g]) + 255u) >> 8); }
    __device__ __forceinline__ bool next(int i, Unit& u) const {
        const int L = i * G + c; if (L >= tb[8] * 16) return false;
        const int rt = L >> 4, pnl = L & 15; int g = 0;
#pragma unroll
        for (int k = 1; k < 8; ++k) g += (rt >= tb[k]) ? 1 : 0;
        u.pm = rt; u.pn = g * 16 + pnl; return true;
    }
    __device__ __forceinline__ void a_ready(const Unit&) const {}
    __device__ __forceinline__ void done(const Unit&) const {}
};
typedef int i32x4_f8 __attribute__((ext_vector_type(4))); typedef int i32x8_f8 __attribute__((ext_vector_type(8)));
__device__ __forceinline__ i32x8_f8 cat8(const bf16x8 a, const bf16x8 b) { return __builtin_shufflevector(__builtin_bit_cast(i32x4_f8, a), __builtin_bit_cast(i32x4_f8, b), 0, 1, 2, 3, 4, 5, 6, 7); }
template <int OA, int OB, int BFMT> __device__ __forceinline__ f32x4 mfma8(const i32x8_f8 a, const i32x8_f8 b, const f32x4 c, int sa, int sb) { return __builtin_amdgcn_mfma_scale_f32_16x16x128_f8f6f4(a, b, c, 0, BFMT, OA, sa, OB, sb); }
template <class Epi, class Sched, bool ALIGN_EPI = false, bool SP2 = false, int F8 = 0>
__device__ __forceinline__ void gemm_phase(PG8_LAS unsigned char* lds, const Gemm g, const Sched& S, const Epi& E) {
    const int tid = threadIdx.x, wid = __builtin_amdgcn_readfirstlane(tid >> 6), lane = tid & 63, wr = wid >> 2, wc = wid & 3, fr = lane & 15, fq = lane >> 4;
    const int K = g.K, nt = K / BK;
    unsigned voffA[2], voffB[2];
#pragma unroll
    for (int i = 0; i < 2; ++i) { int R, C; stage_rc(tid * 16 + i * 8192, R, C); const int Rb = Epi::PERM ? ((R & ~31) + perm32(R & 31)) : R;
        voffA[i] = (unsigned)(R * K + C) * 2u; voffB[i] = (unsigned)(Rb * K + C) * 2u; }
    const size_t kstep = (size_t)(BK * 2);
    const size_t hstep = (size_t)HALF * K * 2;
    const size_t tstep = 2 * hstep;
    const unsigned ldsw = (unsigned)wid * 1024u;
    const int aoff = lds_byte(wr * 64 + fr, fq * 8), boff = lds_byte(wc * 32 + fr, fq * 8);
#define PG8_SA(b, h) (((b) * 2 + (h)) * HTB)
#define PG8_SB(b, h) ((4 + (b) * 2 + (h)) * HTB)
#define PG8_STAGE(bufoff, gbase, voff) do { _Pragma("unroll") for (int _i = 0; _i < 2; ++_i) { unsigned _vo = (voff)[_i]; if constexpr (F8 != 0) asm volatile("" : "+v"(_vo)); \
        __builtin_amdgcn_global_load_lds((const unsigned*)((const char*)(gbase) + _vo), (PG8_LAS unsigned*)(lds + (bufoff) + ldsw + _i * 8192), 16, 0, 0); } } while (0)
#define PG8_LDA(dst, b, h) do { _Pragma("unroll") for (int m = 0; m < 4; ++m) _Pragma("unroll") for (int k = 0; k < 2; ++k) dst[m][k] = *(const PG8_LAS bf16x8*)(lds + PG8_SA(b, h) + aoff + m * 2048 + k * 1024); } while (0)
#define PG8_LDB(dst, b, h) do { _Pragma("unroll") for (int n = 0; n < 2; ++n) _Pragma("unroll") for (int k = 0; k < 2; ++k) dst[n][k] = *(const PG8_LAS bf16x8*)(lds + PG8_SB(b, h) + boff + n * 2048 + k * 1024); } while (0)
#define PG8_M8(ai, bj, m, n, At, Bt) acc[ai][bj][m][n] = mfma8<(bj) * 2 + (n), (m), (F8 == 2 ? 1 : 0)>(cat8(Bt[n][0], Bt[n][1]), cat8(At[m][0], At[m][1]), acc[ai][bj][m][n], (int)sBk, (int)sAc[ai])
#define PG8_MMA(ai, bj, At, Bt) do { __builtin_amdgcn_s_setprio(1); if constexpr (F8 != 0) { PG8_M8(ai, bj, 0, 0, At, Bt); PG8_M8(ai, bj, 0, 1, At, Bt); PG8_M8(ai, bj, 1, 0, At, Bt); PG8_M8(ai, bj, 1, 1, At, Bt); \
        PG8_M8(ai, bj, 2, 0, At, Bt); PG8_M8(ai, bj, 2, 1, At, Bt); PG8_M8(ai, bj, 3, 0, At, Bt); PG8_M8(ai, bj, 3, 1, At, Bt); } else { \
        _Pragma("unroll") for (int m = 0; m < 4; ++m) _Pragma("unroll") for (int n = 0; n < 2; ++n) _Pragma("unroll") for (int k = 0; k < 2; ++k) \
        acc[ai][bj][m][n] = __builtin_amdgcn_mfma_f32_16x16x32_bf16(Bt[n][k], At[m][k], acc[ai][bj][m][n], 0, 0, 0); } __builtin_amdgcn_s_setprio(0); } while (0)
#define PG8_WAIT_V(n) asm volatile("s_waitcnt vmcnt(" #n ")" ::: "memory")
#define PG8_WAIT_L(n) asm volatile("s_waitcnt lgkmcnt(" #n ")" ::: "memory")
#define PG8_BAR __builtin_amdgcn_s_barrier()
#define PG8_SCHED __builtin_amdgcn_sched_barrier(0)
    Unit cur, nxt; int ui = 0;
    if (!S.next(0, cur)) return;
    f32x4 acc[2][2][4][2];
#pragma unroll
    for (int a = 0; a < 2; ++a)
#pragma unroll
        for (int b = 0; b < 2; ++b)
#pragma unroll
            for (int m = 0; m < 4; ++m)
#pragma unroll
                for (int n = 0; n < 2; ++n) acc[a][b][m][n] = (f32x4){0.f, 0.f, 0.f, 0.f};
    bf16x8 At[4][2], B0[2][2], B1[2][2];
    const char* cA = (const char*)g.A + (size_t)cur.pm * tstep; const char* cB = (const char*)g.Bt + (size_t)cur.pn * tstep;
    const char* cS = nullptr; const char* nS = nullptr; unsigned sBk = 0, sBx = 0, sBy = 0, sAc[2] = {0, 0};
    const unsigned soff = (unsigned)(wc * 128 + lane * 2) * 4u, saoff = (unsigned)(wr * 32 + fr) * 4u;
    const size_t sstep = (size_t)(nt >> 1) * 2048;
    if constexpr (F8 != 0) { cS = (const char*)g.sB + (size_t)cur.pn * sstep; sBx = *(const unsigned*)(cS + soff); sBy = *(const unsigned*)(cS + soff + 4); }
    if constexpr (F8 == 1) { const char* sa = (const char*)g.sA + (size_t)cur.pm * 256; sAc[0] = *(const unsigned*)(sa + saoff); sAc[1] = *(const unsigned*)(sa + saoff + 64); }
    if constexpr (F8 == 2) { sAc[0] = 0x7f7f7f7fu; sAc[1] = 0x7f7f7f7fu; }
    const char* cSA = nullptr; const char* nSA = nullptr; unsigned sAn[2] = {0, 0}; const size_t sastep = (size_t)(nt >> 1) * 256;
    if constexpr (F8 == 3) { cSA = (const char*)g.sA + (size_t)cur.pm * sastep; sAc[0] = *(const unsigned*)(cSA + saoff); sAc[1] = *(const unsigned*)(cSA + saoff + 64); }
    S.a_ready(cur);
    if constexpr (SP2) {
        PG8_STAGE(PG8_SB(0, 0), cB, voffB); PG8_STAGE(PG8_SB(0, 1), cB + hstep, voffB); PG8_STAGE(PG8_SA(0, 0), cA, voffA); PG8_STAGE(PG8_SA(0, 1), cA + hstep, voffA);
        if (wr == 1) PG8_BAR;
        PG8_WAIT_V(2); PG8_BAR;
        PG8_STAGE(PG8_SB(1, 0), cB + kstep, voffB); PG8_STAGE(PG8_SA(1, 0), cA + kstep, voffA); PG8_STAGE(PG8_SB(1, 1), cB + hstep + kstep, voffB);
        PG8_WAIT_V(6); PG8_BAR;
    } else {
        PG8_STAGE(PG8_SB(0, 0), cB, voffB); PG8_STAGE(PG8_SA(0, 0), cA, voffA); PG8_STAGE(PG8_SB(0, 1), cB + hstep, voffB); PG8_STAGE(PG8_SA(0, 1), cA + hstep, voffA);
        if (wr == 1) PG8_BAR;
        PG8_WAIT_V(4); PG8_BAR;
        PG8_STAGE(PG8_SB(1, 0), cB + kstep, voffB); PG8_STAGE(PG8_SA(1, 0), cA + kstep, voffA); PG8_STAGE(PG8_SB(1, 1), cB + hstep + kstep, voffB);
        PG8_WAIT_V(6); PG8_BAR;
    }
    for (;;) {
        const bool has_next = S.next(ui + 1, nxt);
        const char* nA = has_next ? (const char*)g.A + (size_t)nxt.pm * tstep : cA; const char* nB = has_next ? (const char*)g.Bt + (size_t)nxt.pn * tstep : cB;
        if constexpr (F8 != 0) nS = has_next ? (const char*)g.sB + (size_t)nxt.pn * sstep : cS;
        if constexpr (F8 == 3) nSA = has_next ? (const char*)g.sA + (size_t)nxt.pm * sastep : cSA;
        for (int t = 0; t < nt; t += 2) {
            const bool last = (t == nt - 2);
            const char* a1 = cA + (size_t)(t + 1) * kstep;
            const char* a2 = last ? nA : cA + (size_t)(t + 2) * kstep; const char* b2 = last ? nB : cB + (size_t)(t + 2) * kstep;
            const char* a3 = a2 + kstep; const char* b3 = b2 + kstep;
            if (last && has_next) S.a_ready(nxt);
            if constexpr (F8 == 3) { const char* a2 = last ? nSA : cSA + ((t >> 1) + 1) * 256; sAn[0] = *(const unsigned*)(a2 + saoff); sAn[1] = *(const unsigned*)(a2 + saoff + 64); }
            const char* s2 = nullptr; if constexpr (F8 != 0) { s2 = last ? nS : cS + ((t >> 1) + 1) * 2048; sBk = sBx; }
            if constexpr (Epi::MIDK) { if (t == E.tsplit) { PG8_WAIT_V(0); PG8_SCHED; E.mid(acc, cur, wr, wc, fr, fq); PG8_WAIT_V(0); PG8_SCHED; } }
            if constexpr (SP2) {
            PG8_LDB(B0, 0, 0); PG8_LDB(B1, 0, 1); PG8_SCHED; PG8_LDA(At, 0, 0); PG8_STAGE(PG8_SA(1, 1), a1 + hstep, voffA);
            PG8_WAIT_V(8); PG8_WAIT_L(0); PG8_BAR; PG8_MMA(0, 0, At, B0); PG8_MMA(0, 1, At, B1); PG8_BAR; PG8_SCHED;
            PG8_LDA(At, 0, 1); PG8_STAGE(PG8_SB(0, 0), b2, voffB); PG8_STAGE(PG8_SB(0, 1), b2 + hstep, voffB); PG8_STAGE(PG8_SA(0, 0), a2, voffA);
            PG8_WAIT_V(8); PG8_WAIT_L(0); PG8_BAR; PG8_MMA(1, 0, At, B0); PG8_MMA(1, 1, At, B1); PG8_BAR; PG8_SCHED;
            if constexpr (F8 != 0) { sBx = *(const unsigned*)(s2 + soff); sBk = sBy; }
            PG8_LDB(B0, 1, 0); PG8_LDB(B1, 1, 1); PG8_SCHED; PG8_LDA(At, 1, 0); PG8_STAGE(PG8_SA(0, 1), a2 + hstep, voffA);
            PG8_WAIT_V(8); PG8_WAIT_L(0); PG8_BAR; PG8_MMA(0, 0, At, B0); PG8_MMA(0, 1, At, B1); PG8_BAR; PG8_SCHED;
            PG8_LDA(At, 1, 1); PG8_STAGE(PG8_SB(1, 0), b3, voffB); PG8_STAGE(PG8_SB(1, 1), b3 + hstep, voffB); PG8_STAGE(PG8_SA(1, 0), a3, voffA);
            PG8_WAIT_V(8); PG8_WAIT_L(0); PG8_BAR; PG8_MMA(1, 0, At, B0); PG8_MMA(1, 1, At, B1); PG8_BAR; PG8_SCHED;
            if constexpr (F8 != 0) sBy = *(const unsigned*)(s2 + soff + 4);
            if constexpr (F8 == 3) { sAc[0] = sAn[0]; sAc[1] = sAn[1]; }
            } else {
            PG8_LDB(B0, 0, 0); PG8_SCHED; PG8_LDA(At, 0, 0); PG8_STAGE(PG8_SA(1, 1), a1 + hstep, voffA);
            PG8_WAIT_L(8); PG8_BAR; PG8_WAIT_L(0); PG8_MMA(0, 0, At, B0); PG8_BAR; PG8_SCHED;
            PG8_LDB(B1, 0, 1); PG8_STAGE(PG8_SB(0, 0), b2, voffB);
            PG8_BAR; PG8_WAIT_L(0); PG8_MMA(0, 1, At, B1); PG8_BAR;
            PG8_LDA(At, 0, 1); PG8_STAGE(PG8_SA(0, 0), a2, voffA);
            PG8_BAR; PG8_WAIT_L(0); PG8_MMA(1, 0, At, B0); PG8_BAR; PG8_SCHED;
            PG8_STAGE(PG8_SB(0, 1), b2 + hstep, voffB);
            PG8_WAIT_V(6); PG8_BAR; PG8_MMA(1, 1, At, B1); PG8_BAR;
            PG8_LDB(B0, 1, 0); PG8_SCHED; PG8_LDA(At, 1, 0); PG8_STAGE(PG8_SA(0, 1), a2 + hstep, voffA);
            PG8_WAIT_L(8); PG8_BAR; PG8_WAIT_L(0); PG8_MMA(0, 0, At, B0); PG8_BAR; PG8_SCHED;
            PG8_LDB(B1, 1, 1); PG8_STAGE(PG8_SB(1, 0), b3, voffB);
            PG8_BAR; PG8_WAIT_L(0); PG8_MMA(0, 1, At, B1); PG8_BAR;
            PG8_LDA(At, 1, 1); PG8_STAGE(PG8_SA(1, 0), a3, voffA);
            PG8_BAR; PG8_WAIT_L(0); PG8_MMA(1, 0, At, B0); PG8_BAR; PG8_SCHED;
            PG8_STAGE(PG8_SB(1, 1), b3 + hstep, voffB);
            PG8_WAIT_V(6); PG8_BAR; PG8_MMA(1, 1, At, B1); PG8_BAR;
            }
        }
        if constexpr (ALIGN_EPI) { if (wr == 0) PG8_BAR; }
        if constexpr (!Epi::AFTER_DRAIN) { int fr2 = fr, fq2 = fq; asm volatile("" : "+v"(fr2), "+v"(fq2));
            E(acc, cur, wr, wc, fr2, fq2); S.done(cur); }
        if (!has_next) break;
#pragma unroll
        for (int a = 0; a < 2; ++a)
#pragma unroll
            for (int b = 0; b < 2; ++b)
#pragma unroll
                for (int m = 0; m < 4; ++m)
#pragma unroll
                    for (int n = 0; n < 2; ++n) acc[a][b][m][n] = (f32x4){0.f, 0.f, 0.f, 0.f};
        cur = nxt; cA = nA; cB = nB; ++ui;
        if constexpr (F8 != 0) cS = nS;
        if constexpr (F8 == 3) cSA = nSA;
        if constexpr (F8 == 1) { const char* sa = (const char*)g.sA + (size_t)cur.pm * 256; sAc[0] = *(const unsigned*)(sa + saoff); sAc[1] = *(const unsigned*)(sa + saoff + 64); }
        if constexpr (ALIGN_EPI) { if (wr == 1) PG8_BAR; }
    }
    PG8_WAIT_V(0);
    if constexpr (!ALIGN_EPI) { if (wr == 0) PG8_BAR; }
    PG8_BAR;
    if constexpr (Epi::AFTER_DRAIN) { E.fused(acc, cur, wr, wc, fr, fq, lds, wid, lane); S.done(cur); }
#undef PG8_SA
#undef PG8_SB
#undef PG8_STAGE
#undef PG8_LDA
#undef PG8_LDB
#undef PG8_MMA
#undef PG8_M8
#undef PG8_WAIT_V
#undef PG8_WAIT_L
#undef PG8_BAR
#undef PG8_SCHED
}
}
constexpr int NWAVES = 8, NTHR = 512;
constexpr int T = 8704, TP = 8192, DM = 4096, LDH = pg8::LDH;
constexpr int C_Z = pg8::C_Z, C_XBC = pg8::C_XBC, C_U = pg8::C_U, C_V = pg8::C_V, C_G1 = pg8::C_G1, C_G2 = pg8::C_G2;
constexpr int XG_ROWS = 10752;
constexpr float LN_EPS = 1e-5f, RMS_EPS = 1e-5f;
constexpr size_t MiB = 1u << 20;
constexpr size_t WS_CTL = 0, CTL_ZERO_BYTES = 64 * 1024;
constexpr size_t WS_WIN = 1 * MiB;
constexpr size_t WS_WP = WS_WIN + 178 * MiB;
constexpr size_t WS_WOUT = WS_WP + 48 * MiB;
constexpr size_t WS_WGU = WS_WOUT + 32 * MiB;
constexpr size_t WS_WDN = WS_WGU + 256 * MiB;
constexpr size_t WS_XB = WS_WDN + 128 * MiB;
constexpr size_t WS_H = WS_XB + 68 * MiB;
constexpr size_t WS_XG = WS_H, WS_HM = WS_H + 96 * MiB;
constexpr size_t WS_SBGU = WS_WGU + 128 * MiB, WS_SBDN = WS_WGU + 132 * MiB, WS_SAXG = WS_WGU + 134 * MiB;
constexpr size_t WS_DT = WS_H + 379 * MiB;
constexpr size_t WS_YRAW = WS_DT + 3 * MiB;
constexpr size_t WS_X8 = WS_YRAW, WS_W8 = WS_YRAW + 34 * MiB, WS_SB8 = WS_YRAW + 123 * MiB, WS_SA8 = WS_YRAW + 126 * MiB;
constexpr size_t WS_YCAT = WS_YRAW + 136 * MiB;
constexpr size_t WS_MRG = WS_YCAT + 102 * MiB;
constexpr size_t WS_R1 = WS_MRG + 68 * MiB;
constexpr size_t WS_SMALL = WS_R1 + 136 * MiB;
constexpr size_t WS_WRF = WS_SMALL + 1 * MiB;
constexpr size_t WS_G8 = WS_WRF + 1 * MiB;
constexpr size_t WS_END = WS_G8 + 68 * MiB;
constexpr size_t SM_GRP = 0, SM_RANK = 65536, SM_GW = 131072, SM_TOK = 327680, SM_GWS = 393216;
constexpr int CW_CNT = 64;
constexpr int CW_BAR = 4096;
constexpr int RING_BYTES = 131072, MISC_OFF = 139264 + 320  , LDS_BYTES = 147456;

#define GAS __attribute__((address_space(1)))
#define LAS __attribute__((address_space(3)))
typedef unsigned short bf16;
typedef unsigned v4u __attribute__((ext_vector_type(4)));
typedef unsigned v2u __attribute__((ext_vector_type(2)));
typedef float f32x4 __attribute__((ext_vector_type(4)));
typedef GAS unsigned gu32;
#define RLX_AGENT __ATOMIC_RELAXED, __HIP_MEMORY_SCOPE_AGENT
#define LDS_WAIT() asm volatile("s_waitcnt lgkmcnt(0)" ::: "memory")
#define VM_WAIT() asm volatile("s_waitcnt vmcnt(0)" ::: "memory")
typedef float f32x2_pk __attribute__((ext_vector_type(2))); typedef __bf16 bf16x2_pk __attribute__((ext_vector_type(2)));
__device__ __forceinline__ unsigned pk2(float lo, float hi) { const f32x2_pk v = {lo, hi}; const bf16x2_pk b = __builtin_convertvector(v, bf16x2_pk); return __builtin_bit_cast(unsigned, b); }
__device__ __forceinline__ unsigned f2bf(float f) { return pk2(f, 0.f) & 0xffffu; }
__device__ __forceinline__ float bflo(unsigned w) { return __builtin_bit_cast(float, w << 16); }
__device__ __forceinline__ float bfhi(unsigned w) { return __builtin_bit_cast(float, w & 0xffff0000u); }
__device__ __forceinline__ float wave_sum(float v) {
#pragma unroll
    for (int o = 1; o < 64; o <<= 1) v += __shfl_xor(v, o);
    return v;
}
__device__ __forceinline__ float sigmf(float a) { return 1.0f / (1.0f + __expf(-a)); }
#define XB_TMO      128
#define XB_XCNT(j)  (256  + 64 * (j))
#define XB_XSUB(j)  (1280 + 64 * (j))
#define XB_XGEN(j)  (2304 + 64 * (j))
#define XB_TOP      3328
#define XB_TOPGEN   3392
#define XCD_BAR_WORDS 3456
#define XB_SPIN_CAP (1u << 18)

__device__ __forceinline__ unsigned xb_ld(unsigned* p)              { return __hip_atomic_load(p, __ATOMIC_RELAXED, __HIP_MEMORY_SCOPE_AGENT); }
__device__ __forceinline__ unsigned xb_add(unsigned* p, unsigned v) { return __hip_atomic_fetch_add(p, v, __ATOMIC_RELAXED, __HIP_MEMORY_SCOPE_AGENT); }
__device__ __forceinline__ unsigned xb_xcc_id() { return (unsigned)__builtin_amdgcn_s_getreg((3 << 11) | 20) & 0xFu; }
#define XB_SPIN(cond, bar) do { unsigned _sp = 0; while (cond) { __builtin_amdgcn_s_sleep(1); \
    if ((++_sp & 255u) == 0u) { if (xb_ld(&(bar)[XB_TMO])) break; if (_sp > XB_SPIN_CAP) { atomicAdd(&(bar)[XB_TMO], 1u); break; } } } } while (0)

struct XcdBarrier {
    unsigned* bar; unsigned x;
    volatile LAS unsigned* st;
};

__device__ __forceinline__ XcdBarrier xcd_barrier_post(unsigned* bar, volatile LAS unsigned* st) {
    XcdBarrier b; b.bar = bar; b.x = xb_xcc_id(); b.st = st;
    if (threadIdx.x == 0) (void)xb_add(&bar[XB_XCNT(b.x)], 1u);
    return b;
}
__device__ __forceinline__ void xcd_barrier_complete(unsigned* bar, unsigned x, unsigned& nloc, unsigned& nx) {
    const unsigned G = gridDim.x * gridDim.y * gridDim.z;
    unsigned sum, cnt, mine, sp = 0u;
    for (;;) {
        sum = 0u; cnt = 0u; mine = 0u;
#pragma unroll
        for (unsigned j = 0; j < 16; ++j) { const unsigned c = xb_ld(&bar[XB_XCNT(j)]); sum += c; cnt += (c > 0u) ? 1u : 0u; mine = (j == x) ? c : mine; }
        if (sum == G) break;
        __builtin_amdgcn_s_sleep(1);
        if ((++sp & 255u) == 0u) { if (xb_ld(&bar[XB_TMO])) break; if (sp > XB_SPIN_CAP) { atomicAdd(&bar[XB_TMO], 1u); break; } }
    }
    nloc = mine > 0u ? mine : 1u; nx = cnt > 0u ? cnt : 1u;
}

__device__ __forceinline__ void xcd_barrier(const XcdBarrier& b) {
    asm volatile("s_waitcnt vmcnt(0)" ::: "memory");
    __syncthreads();
    if (threadIdx.x == 0) {
        unsigned* bar = b.bar;
        __builtin_amdgcn_s_waitcnt(0);
        unsigned nloc = b.st[0], nx = b.st[1];
        if (nloc == 0u) { xcd_barrier_complete(bar, b.x, nloc, nx); b.st[0] = nloc; b.st[1] = nx; }
        const unsigned old = xb_add(&bar[XB_XSUB(b.x)], 1u);
        const unsigned gen = old / nloc;
        if (old + 1u == (gen + 1u) * nloc) {
            __builtin_amdgcn_fence(__ATOMIC_RELEASE, "agent");
            asm volatile("s_waitcnt vmcnt(0)" ::: "memory");
            const unsigned og = xb_add(&bar[XB_TOP], 1u);
            const unsigned tg = og / nx;
            if (og + 1u == (tg + 1u) * nx) xb_add(&bar[XB_TOPGEN], 1u);
            else XB_SPIN(xb_ld(&bar[XB_TOPGEN]) == tg, bar);
            __builtin_amdgcn_fence(__ATOMIC_ACQUIRE, "agent");
            xb_add(&bar[XB_XGEN(b.x)], 1u);
            asm volatile("s_waitcnt vmcnt(0)" ::: "memory");
        } else {
            XB_SPIN(xb_ld(&bar[XB_XGEN(b.x)]) == gen, bar);
            __builtin_amdgcn_fence(__ATOMIC_ACQUIRE, "agent");
            asm volatile("s_waitcnt vmcnt(0)" ::: "memory");
        }
    }
    __syncthreads();
}
#ifndef REP_SSDP
#define REP_SSDP 1
#endif
#ifndef REP_SSDS
#define REP_SSDS 1
#endif
#ifndef REP_P2
#define REP_P2 1
#endif
#ifndef REP_P11
#define REP_P11 1
#endif
#ifndef REP_P5
#define REP_P5 1
#endif
#ifndef REP_P6
#define REP_P6 1
#endif
#ifndef REP_P9
#define REP_P9 1
#endif
#ifndef REP_P10
#define REP_P10 1
#endif
#ifndef REP_P0
#define REP_P0 1
#endif
#ifndef REP_P1
#define REP_P1 1
#endif
#ifndef REP_SSD
#define REP_SSD 1
#endif
#ifndef REP_RT
#define REP_RT 1
#endif
#ifndef REP_P4
#define REP_P4 1
#endif
__device__ __forceinline__ void tr_item(const float* W, size_t ldw, int k0, int n0, bf16* dst, size_t ldd, int drow0, int dcol0, LAS float* scr, int lane) {
#pragma unroll 8
    for (int i = 0; i < 32; ++i) { const int kk = 2 * i + (lane >> 5); scr[kk * 33 + (lane & 31)] = W[(size_t)(k0 + kk) * ldw + n0 + (lane & 31)]; }
    LDS_WAIT(); asm volatile("" ::: "memory");
    const int c = lane & 7;
#pragma unroll
    for (int j = 0; j < 4; ++j) { const int n = (lane >> 3) + 8 * j; const LAS float* s = scr + (8 * c) * 33 + n;
        v4u o; o.x = pk2(s[0 * 33], s[1 * 33]); o.y = pk2(s[2 * 33], s[3 * 33]); o.z = pk2(s[4 * 33], s[5 * 33]); o.w = pk2(s[6 * 33], s[7 * 33]);
        *(v4u*)(dst + (size_t)(drow0 + n) * ldd + dcol0 + k0 + 8 * c) = o; }
    LDS_WAIT(); asm volatile("" ::: "memory");
}
using pg8::e8m0_of; using pg8::e8m0_inv; using pg8::pk4_fp8;
__device__ __forceinline__ void tr_item8(const float* W, size_t ldw, int k0, int n0, unsigned char* dst, unsigned char* sb8, int drow0, LAS float* scr, int lane, int rowb = 4096, int dcol0 = 0, int pairs = 16) {
#pragma unroll 8
    for (int i = 0; i < 64; ++i) { const int kk = 2 * i + (lane >> 5); scr[kk * 33 + (lane & 31)] = W[(size_t)(k0 + kk) * ldw + n0 + (lane & 31)]; }
    LDS_WAIT(); asm volatile("" ::: "memory");
    const int c = lane & 7, kt = (dcol0 + k0) >> 7;
#pragma unroll
    for (int j = 0; j < 4; ++j) { const int n = (lane >> 3) + 8 * j; const LAS float* sp = scr + (16 * c) * 33 + n;
        float v[16]; float am = 0.f;
#pragma unroll
        for (int i = 0; i < 16; ++i) { v[i] = sp[i * 33]; am = fmaxf(am, fabsf(v[i])); }
        am = fmaxf(am, __shfl_xor(am, 1)); am = fmaxf(am, __shfl_xor(am, 2)); am = fmaxf(am, __shfl_xor(am, 4));
        const int sb = e8m0_of(am); const float inv = e8m0_inv(sb);
        v4u o; o.x = pk4_fp8(v[0] * inv, v[1] * inv, v[2] * inv, v[3] * inv); o.y = pk4_fp8(v[4] * inv, v[5] * inv, v[6] * inv, v[7] * inv);
        o.z = pk4_fp8(v[8] * inv, v[9] * inv, v[10] * inv, v[11] * inv); o.w = pk4_fp8(v[12] * inv, v[13] * inv, v[14] * inv, v[15] * inv);
        const int nrow = drow0 + n;
        *(v4u*)(dst + (size_t)nrow * rowb + dcol0 + k0 + 16 * c) = o;
        if (c < 4) { const int pn = nrow >> 8, rr = nrow & 255, bj = rr >> 7, wcc = (rr >> 5) & 3, pp = rr & 31, fr = 4 * (pp >> 3) + (pp & 3), nn = (pp >> 2) & 1;
            sb8[((((size_t)(pn * pairs + (kt >> 1)) * 4 + wcc) * 64 + c * 16 + fr) * 2 + (kt & 1)) * 4 + bj * 2 + nn] = (unsigned char)sb; }
    }
    LDS_WAIT(); asm volatile("" ::: "memory");
}
struct P0Args { const float *w_in, *p_ssd, *p_sg, *w_out, *w_gate, *w_up, *w_down, *xp, *xs; bf16 *Wt_in, *Wt_p, *Wt_out, *Wt_gu, *Wt_dn, *xb; const float *w_rg, *w_re; v4u* wrf; unsigned char *x8, *W8, *sb8, *sa8, *Wgu8, *Wdn8, *sbgu, *sbdn, *Wo8, *sbwo, *Wp8, *sbwp; };
__device__ __forceinline__ void moe_item8(const P0Args& a, int r, LAS float* scr, int lane) {
    constexpr int I_EX = 32 * 512;
    if (r < 2 * I_EX) { const int up = r >= I_EX ? 1 : 0; if (up) r -= I_EX;
        const int e = r >> 9, q = r & 511, kb = q >> 4, n0 = (q & 15) * 32;
        const int g = e >> 2, el = e & 3, drow = g * 4096 + el * 1024 + (n0 >> 7) * 256 + up * 128 + (n0 & 127);
        tr_item8((up ? a.w_up : a.w_gate) + (size_t)e * 4096 * 512, 512, kb * 128, n0, a.Wgu8, a.sbgu, drow, scr, lane, 4096, 0, 16); return; } r -= 2 * I_EX;
    { const int e = r >> 9, q = r & 511, kb = q >> 7, n0 = (q & 127) * 32;
        const int g = e >> 2, el = e & 3;
        tr_item8(a.w_down + (size_t)e * 512 * 4096, 4096, kb * 128, n0, a.Wdn8, a.sbdn, g * 4096 + n0, scr, lane, 2048, el * 512, 8); }
}
__device__ __forceinline__ void p0_convert(const P0Args& a, LAS unsigned char* lds, int gw, int NGW, int wave, int lane, bool with_moe) {
    LAS float* scr = (LAS float*)(lds + wave * 17408);
    constexpr int I_IN = 64 * 706, I_PS = 32 * 128, I_PG = 16 * 128, I_WO = 64 * 128, I_EX = 32 * 512;
    const int NITEMS = I_IN + I_PS + I_PG + (with_moe ? I_WO + 3 * I_EX : 0);
    for (int it = gw; it < NITEMS; it += NGW) {
        int r = it;
        if (r < I_IN) { const int kb = r / 706, n0 = (r % 706) * 32; const int drow = n0 < 10240 ? n0 : (n0 < 10304 ? n0 - 10240 + 22528 : n0 - 64);
            const bool f8 = drow < 4096 || (drow >= 10240 && drow < 12288) || (drow >= 14336 && drow < 22528);
            const bool vcol = drow >= 12288 && drow < 14336;
            if (!f8) tr_item(a.w_in, 22592, kb * 64, n0, a.Wt_in, 4096, drow, 0, scr, lane);
            if ((f8 || vcol) && !(kb & 1)) tr_item8(a.w_in, 22592, kb * 64, n0, a.W8, a.sb8, drow, scr, lane);
            continue; } r -= I_IN;
        if (r < I_PS) { const int kb = r / 128, n0 = (r % 128) * 32; tr_item8(a.p_ssd, 4096, kb * 128, n0, a.Wp8, a.sbwp, n0, scr, lane, 6144, 0, 24); continue; } r -= I_PS;
        if (r < I_PG) { const int kb = r / 128, n0 = (r % 128) * 32; tr_item8(a.p_sg, 4096, kb * 128, n0, a.Wp8, a.sbwp, n0, scr, lane, 6144, 4096, 24); continue; } r -= I_PG;
        if (r < I_WO) { const int kb = r / 128, n0 = (r % 128) * 32; if (!(kb & 1)) tr_item8(a.w_out, 4096, kb * 64, n0, a.Wo8, a.sbwo, n0, scr, lane, 4096, 0, 16); continue; } r -= I_WO;
        moe_item8(a, r, scr, lane);
    }
    for (int it = gw * 64 + lane; it < 128 * 3 * 64; it += NGW * 64) { const int l = it & 63, c = (it >> 6) % 3, sk = it / 192, o = 16 * c + (l & 15), k0 = 32 * sk + 8 * (l >> 4);
        float v[8];
#pragma unroll
        for (int jj = 0; jj < 8; ++jj) v[jj] = o < 32 ? a.w_re[(size_t)(k0 + jj) * 32 + o] : (o < 40 ? a.w_rg[(size_t)(k0 + jj) * 8 + (o - 32)] : 0.f);
        v4u hi, lo; unsigned hw[4], lw[4];
#pragma unroll
        for (int j2 = 0; j2 < 4; ++j2) { hw[j2] = pk2(v[2 * j2], v[2 * j2 + 1]); lw[j2] = pk2(v[2 * j2] - bflo(hw[j2]), v[2 * j2 + 1] - bfhi(hw[j2])); }
        hi.x = hw[0]; hi.y = hw[1]; hi.z = hw[2]; hi.w = hw[3]; lo.x = lw[0]; lo.y = lw[1]; lo.z = lw[2]; lo.w = lw[3];
        a.wrf[((size_t)(sk * 3 + c) * 2 + 0) * 64 + l] = hi; a.wrf[((size_t)(sk * 3 + c) * 2 + 1) * 64 + l] = lo; }
    for (int row = gw; row < T; row += NGW) {
        const float* s = row < TP ? a.xp + (size_t)row * 4096 : a.xs + (size_t)(row - TP) * 4096;
        f32x4 v[16]; float am = 0.f;
#pragma unroll
        for (int i = 0; i < 8; ++i) { v[2 * i] = *(const f32x4*)(s + 8 * (i * 64 + lane)); v[2 * i + 1] = *(const f32x4*)(s + 8 * (i * 64 + lane) + 4); }
#pragma unroll
        for (int i = 0; i < 16; ++i) am = fmaxf(fmaxf(am, fmaxf(fabsf(v[i][0]), fabsf(v[i][1]))), fmaxf(fabsf(v[i][2]), fabsf(v[i][3])));
#pragma unroll
        for (int d = 1; d < 64; d <<= 1) am = fmaxf(am, __shfl_xor(am, d));
        const int sb = e8m0_of(am); const float inv = e8m0_inv(sb);
#pragma unroll
        for (int i = 0; i < 8; ++i) { const f32x4 v0 = v[2 * i], v1 = v[2 * i + 1];
            v4u o; o.x = pk2(v0[0], v0[1]); o.y = pk2(v0[2], v0[3]); o.z = pk2(v1[0], v1[1]); o.w = pk2(v1[2], v1[3]);
            *(v4u*)(a.xb + (size_t)row * 4096 + 8 * (i * 64 + lane)) = o;
            v2u q; q.x = pk4_fp8(v0[0] * inv, v0[1] * inv, v0[2] * inv, v0[3] * inv); q.y = pk4_fp8(v1[0] * inv, v1[1] * inv, v1[2] * inv, v1[3] * inv);
            *(v2u*)(a.x8 + (size_t)row * 4096 + 8 * (i * 64 + lane)) = q; }
        if (lane == 0) a.sa8[(((((row >> 8) * 2 + ((row >> 6) & 1)) * 2 + ((row >> 7) & 1)) * 16 + (row & 15)) * 4) + ((row >> 4) & 3)] = (unsigned char)sb;
    }
}

__device__ __forceinline__ void conv_wout(const P0Args& a, LAS unsigned char* lds, int wi, int NW, int wave, int lane) {
    LAS float* scr = (LAS float*)(lds + wave * 17408);
    for (int r = wi; r < 32 * 128; r += NW) { const int kb = r / 128, n0 = (r % 128) * 32; tr_item8(a.w_out, 4096, kb * 128, n0, a.Wo8, a.sbwo, n0, scr, lane, 4096, 0, 16); }
}
__device__ __forceinline__ void conv_moe(const P0Args& a, LAS unsigned char* lds, int lo, int hi, int wi, int NW, int wave, int lane) {
    LAS float* scr = (LAS float*)(lds + wave * 17408);
    for (int it = lo + wi; it < hi; it += NW) moe_item8(a, it, scr, lane);
}

__device__ __forceinline__ void unpack8(const v4u w, float (&v)[8]) { v[0] = bflo(w.x); v[1] = bfhi(w.x); v[2] = bflo(w.y); v[3] = bfhi(w.y); v[4] = bflo(w.z); v[5] = bfhi(w.z); v[6] = bflo(w.w); v[7] = bfhi(w.w); }
__device__ __forceinline__ void p2_conv(const bf16* H, const float* conv_state, const float* conv_w, const float* conv_b, bf16* xbcc, float* out_conv_p, float* out_conv_s, size_t gtid, size_t gthreads) {
    constexpr int NPI = 512 * 768, NSI = 128 * 768;
    for (size_t idx = gtid; idx < (size_t)(NPI + NSI); idx += gthreads) {
        const bool smp = idx >= (size_t)NPI; const int id = smp ? (int)(idx - NPI) : (int)idx;
        const int c = (id % 768) * 8, run = id / 768;
        const int row0 = smp ? TP + run * 4 : run * 16, nr = smp ? 4 : 16, t0 = smp ? 0 : (row0 & 2047);
        float wk[4][8], bias[8];
#pragma unroll
        for (int k = 0; k < 4; ++k) { const f32x4 w0 = *(const f32x4*)(conv_w + k * 6144 + c), w1 = *(const f32x4*)(conv_w + k * 6144 + c + 4);
#pragma unroll
            for (int j = 0; j < 4; ++j) { wk[k][j] = w0[j]; wk[k][4 + j] = w1[j]; } }
        { const f32x4 b0 = *(const f32x4*)(conv_b + c), b1 = *(const f32x4*)(conv_b + c + 4);
#pragma unroll
          for (int j = 0; j < 4; ++j) { bias[j] = b0[j]; bias[4 + j] = b1[j]; } }
        v4u rw[16];
#pragma unroll
        for (int r = 0; r < 16; ++r) if (r < nr) rw[r] = *(const v4u*)(H + (size_t)(row0 + r) * LDH + C_XBC + c);
        float h0[8], h1[8], h2[8];
        if (smp) { const float* sp = conv_state + (size_t)run * 3 * 6144 + c;
            const f32x4 a0 = *(const f32x4*)(sp), a1 = *(const f32x4*)(sp + 4), b0 = *(const f32x4*)(sp + 6144), b1 = *(const f32x4*)(sp + 6144 + 4), c0 = *(const f32x4*)(sp + 12288), c1 = *(const f32x4*)(sp + 12288 + 4);
#pragma unroll
            for (int j = 0; j < 4; ++j) { h0[j] = a0[j]; h0[4 + j] = a1[j]; h1[j] = b0[j]; h1[4 + j] = b1[j]; h2[j] = c0[j]; h2[4 + j] = c1[j]; } }
        else if (t0 > 0) { unpack8(*(const v4u*)(H + (size_t)(row0 - 3) * LDH + C_XBC + c), h0); unpack8(*(const v4u*)(H + (size_t)(row0 - 2) * LDH + C_XBC + c), h1); unpack8(*(const v4u*)(H + (size_t)(row0 - 1) * LDH + C_XBC + c), h2); }
        else {
#pragma unroll
            for (int j = 0; j < 8; ++j) { h0[j] = 0.f; h1[j] = 0.f; h2[j] = 0.f; } }
#pragma unroll
        for (int r = 0; r < 16; ++r) if (r < nr) {
            float cur[8]; unpack8(rw[r], cur);
            float acc[8];
#pragma unroll
            for (int j = 0; j < 8; ++j) { acc[j] = bias[j] + wk[0][j] * h0[j] + wk[1][j] * h1[j] + wk[2][j] * h2[j] + wk[3][j] * cur[j]; acc[j] = acc[j] * sigmf(acc[j]); }
            v4u o; o.x = pk2(acc[0], acc[1]); o.y = pk2(acc[2], acc[3]); o.z = pk2(acc[4], acc[5]); o.w = pk2(acc[6], acc[7]);
            *(v4u*)(xbcc + (size_t)(row0 + r) * 6144 + c) = o;
            const int t = t0 + r; float* od = nullptr;
            if (!smp && t >= 2045) od = out_conv_p + ((size_t)(row0 >> 11) * 3 + (t - 2045)) * 6144 + c;
            if (smp && t >= 1) od = out_conv_s + ((size_t)run * 3 + (t - 1)) * 6144 + c;
            if (od) { *(f32x4*)od = (f32x4){cur[0], cur[1], cur[2], cur[3]}; *(f32x4*)(od + 4) = (f32x4){cur[4], cur[5], cur[6], cur[7]}; }
#pragma unroll
            for (int j = 0; j < 8; ++j) { h0[j] = h1[j]; h1[j] = h2[j]; h2[j] = cur[j]; }
        }
    }
}

__device__ __forceinline__ void vln_row(bf16* H, const float* g, const float* b, float* out_v, int row, int lane) {
    bf16* rp = H + (size_t)row * LDH + C_V;
    float v[32];
#pragma unroll
    for (int j = 0; j < 4; ++j) { const v4u w = *(const v4u*)(rp + (lane + 64 * j) * 8);
        v[8 * j] = bflo(w.x); v[8 * j + 1] = bfhi(w.x); v[8 * j + 2] = bflo(w.y); v[8 * j + 3] = bfhi(w.y); v[8 * j + 4] = bflo(w.z); v[8 * j + 5] = bfhi(w.z); v[8 * j + 6] = bflo(w.w); v[8 * j + 7] = bfhi(w.w); }
    float s = 0.f;
#pragma unroll
    for (int i = 0; i < 32; ++i) s += v[i];
    const float mean = wave_sum(s) * (1.f / 2048.f); float s2 = 0.f;
#pragma unroll
    for (int i = 0; i < 32; ++i) { v[i] -= mean; s2 += v[i] * v[i]; }
    const float rstd = 1.f / sqrtf(wave_sum(s2) * (1.f / 2048.f) + LN_EPS);
#pragma unroll
    for (int j = 0; j < 4; ++j) { const int c = (lane + 64 * j) * 8;
        const f32x4 g0 = *(const f32x4*)(g + c), g1 = *(const f32x4*)(g + c + 4), b0 = *(const f32x4*)(b + c), b1 = *(const f32x4*)(b + c + 4);
        float o[8];
#pragma unroll
        for (int i = 0; i < 4; ++i) { o[i] = v[8 * j + i] * rstd * g0[i] + b0[i]; o[4 + i] = v[8 * j + 4 + i] * rstd * g1[i] + b1[i]; }
        v4u w; w.x = pk2(o[0], o[1]); w.y = pk2(o[2], o[3]); w.z = pk2(o[4], o[5]); w.w = pk2(o[6], o[7]);
        *(v4u*)(rp + c) = w;
        if (row >= TP) { float* od = out_v + (size_t)(row - TP) * 2048 + c; *(f32x4*)od = (f32x4){o[0], o[1], o[2], o[3]}; *(f32x4*)(od + 4) = (f32x4){o[4], o[5], o[6], o[7]}; } }
}

__device__ __forceinline__ size_t sa_idx(int row, int pair, int npairs) { return ((((size_t)((row >> 8) * npairs + pair) * 2 + ((row >> 6) & 1)) * 2 + ((row >> 7) & 1)) * 16 + (row & 15)) * 4 + ((row >> 4) & 3); }
__device__ __forceinline__ float wave_max(float v) {
#pragma unroll
    for (int d = 1; d < 64; d <<= 1) v = fmaxf(v, __shfl_xor(v, d));
    return v; }
__device__ __forceinline__ void ssdnorm_row(const bf16* yraw, const bf16* H, const float* ng, unsigned char* ycat, unsigned char* say, int row, int lane) {
    v4u yv[8], zv[8];
#pragma unroll
    for (int g = 0; g < 8; ++g) { const int c = g * 512 + lane * 8; yv[g] = *(const v4u*)(yraw + (size_t)row * 4096 + c); zv[g] = *(const v4u*)(H + (size_t)row * LDH + C_Z + c); }
#pragma unroll
    for (int g = 0; g < 8; ++g) { const int c = g * 512 + lane * 8;
        float v[8] = {bflo(yv[g].x) * bflo(zv[g].x), bfhi(yv[g].x) * bfhi(zv[g].x), bflo(yv[g].y) * bflo(zv[g].y), bfhi(yv[g].y) * bfhi(zv[g].y),
                      bflo(yv[g].z) * bflo(zv[g].z), bfhi(yv[g].z) * bfhi(zv[g].z), bflo(yv[g].w) * bflo(zv[g].w), bfhi(yv[g].w) * bfhi(zv[g].w)};
        float ss = 0.f;
#pragma unroll
        for (int i = 0; i < 8; ++i) ss += v[i] * v[i];
        const float r = 1.f / sqrtf(wave_sum(ss) * (1.f / 512.f) + RMS_EPS);
        const f32x4 g0 = *(const f32x4*)(ng + c), g1 = *(const f32x4*)(ng + c + 4);
        float am = 0.f;
#pragma unroll
        for (int i = 0; i < 8; ++i) { v[i] = v[i] * r * (i < 4 ? g0[i] : g1[i - 4]); am = fmaxf(am, fabsf(v[i])); }
        const int sb = e8m0_of(wave_max(am)); const float inv = e8m0_inv(sb);
        *(v2u*)(ycat + (size_t)row * 6144 + c) = (v2u){pk4_fp8(v[0] * inv, v[1] * inv, v[2] * inv, v[3] * inv), pk4_fp8(v[4] * inv, v[5] * inv, v[6] * inv, v[7] * inv)};
        if (lane < 2) say[sa_idx(row, 2 * g + lane, 24)] = (unsigned char)sb; }
}
__device__ __forceinline__ void sgu_item(const bf16* H, const float* sg_w, const float* sg_b, unsigned char* ycat, unsigned char* say, int row, int quarter, int lane) {
    const int c = quarter * 512 + lane * 8, g = c >> 8;
    const int i = row >= TP ? ((row - TP) & 3) : (row & 127);
    const float* wrow = sg_w + ((size_t)g * 128 + i) * 128;
    float acc[8];
#pragma unroll
    for (int k = 0; k < 8; ++k) acc[k] = 0.f;
    const bf16* vp = H + (size_t)(row - i) * LDH + C_V + c;
    for (int j = 0; j <= i; ++j) { const float w = wrow[j]; const v4u x = *(const v4u*)(vp + (size_t)j * LDH);
        acc[0] += w * bflo(x.x); acc[1] += w * bfhi(x.x); acc[2] += w * bflo(x.y); acc[3] += w * bfhi(x.y); acc[4] += w * bflo(x.z); acc[5] += w * bfhi(x.z); acc[6] += w * bflo(x.w); acc[7] += w * bfhi(x.w); }
    const float bb = sg_b[g * 128 + i];
    const v4u u = *(const v4u*)(H + (size_t)row * LDH + C_U + c);
    float o[8] = {bflo(u.x) * (acc[0] + bb), bfhi(u.x) * (acc[1] + bb), bflo(u.y) * (acc[2] + bb), bfhi(u.y) * (acc[3] + bb), bflo(u.z) * (acc[4] + bb), bfhi(u.z) * (acc[5] + bb), bflo(u.w) * (acc[6] + bb), bfhi(u.w) * (acc[7] + bb)};
    float am = 0.f;
#pragma unroll
    for (int k = 0; k < 8; ++k) am = fmaxf(am, fabsf(o[k]));
#pragma unroll
    for (int d = 1; d < 32; d <<= 1) am = fmaxf(am, __shfl_xor(am, d));
    const int sb = e8m0_of(am); const float inv = e8m0_inv(sb);
    *(v2u*)(ycat + (size_t)row * 6144 + 4096 + c) = (v2u){pk4_fp8(o[0] * inv, o[1] * inv, o[2] * inv, o[3] * inv), pk4_fp8(o[4] * inv, o[5] * inv, o[6] * inv, o[7] * inv)};
    if ((lane & 31) == 0) say[sa_idx(row, 16 + g, 24)] = (unsigned char)sb;
}

typedef short s16x4 __attribute__((ext_vector_type(4)));
typedef short bf16x8 __attribute__((ext_vector_type(8)));
__device__ __forceinline__ unsigned off_b(unsigned row, unsigned ch) { return 256u * row + 16u * (ch ^ (((row & 3u) << 2) | ((row >> 2) & 3u))); }
__device__ __forceinline__ unsigned rr16(unsigned lane, unsigned rb, unsigned s) { return off_b((lane & 15u) + 16u * rb, 4u * s + (lane >> 4)); }
__device__ __forceinline__ unsigned tr16(unsigned lane, unsigned c, unsigned ks, unsigned t) { const unsigned g = lane >> 4, q = (lane & 15u) >> 2, p = lane & 3u;
    return off_b(32u * ks + 8u * g + 4u * t + q, 2u * c + (p >> 1)) + 8u * (p & 1u); }
__device__ __forceinline__ bf16x8 ld_row(const LAS unsigned char* p) { return *(const LAS bf16x8*)p; }
__device__ __forceinline__ s16x4 ld_tr4(const LAS unsigned char* p) { return __builtin_bit_cast(s16x4, __builtin_amdgcn_ds_read_tr16_b64_v4i16((LAS s16x4*)p)); }
__device__ __forceinline__ bf16x8 ld_tr(const LAS unsigned char* p0, const LAS unsigned char* p1) { const s16x4 a = ld_tr4(p0), b = ld_tr4(p1); return (bf16x8){a[0], a[1], a[2], a[3], b[0], b[1], b[2], b[3]}; }

__device__ __forceinline__ void sgu_unit(const bf16* H, const float* sg_w, const float* sg_b, unsigned char* ycat, unsigned char* say, int row0, int g, LAS unsigned char* lds, int tid) {
    const int lane = tid & 63, w = __builtin_amdgcn_readfirstlane(tid >> 6), q = lane >> 4, fr = lane & 15;
    LAS unsigned char* Wl = lds; LAS unsigned char* V0 = lds + 32768; LAS unsigned char* V1 = lds + 65536;
    __syncthreads();
#pragma unroll
    for (int k = 0; k < 4; ++k) { const int idx = tid + 512 * k, i = idx >> 4, ch = idx & 15, j0 = ch * 8;
        const float* sp = sg_w + ((size_t)g * 128 + i) * 128 + j0; const f32x4 a = *(const f32x4*)sp, b = *(const f32x4*)(sp + 4);
        v4u o; o.x = pk2(j0 + 0 <= i ? a[0] : 0.f, j0 + 1 <= i ? a[1] : 0.f); o.y = pk2(j0 + 2 <= i ? a[2] : 0.f, j0 + 3 <= i ? a[3] : 0.f);
        o.z = pk2(j0 + 4 <= i ? b[0] : 0.f, j0 + 5 <= i ? b[1] : 0.f); o.w = pk2(j0 + 6 <= i ? b[2] : 0.f, j0 + 7 <= i ? b[3] : 0.f);
        *(LAS v4u*)(Wl + off_b(i, ch)) = o; }
#pragma unroll
    for (int k = 0; k < 8; ++k) { const int idx = tid + 512 * k, j = idx >> 5, c32 = idx & 31;
        const v4u v = *(const v4u*)(H + (size_t)(row0 + j) * LDH + C_V + g * 256 + c32 * 8);
        *(LAS v4u*)((c32 < 16 ? V0 : V1) + off_b(j, c32 & 15)) = v; }
    __syncthreads();
    const int I = w;
    bf16x8 wf[4];
#pragma unroll
    for (int ks = 0; ks < 4; ++ks) wf[ks] = ld_row(Wl + rr16(lane, I, ks));
    const int irow = row0 + 16 * I + fr; const float bias = sg_b[g * 128 + 16 * I + fr];
    f32x4 o[16]; float am = 0.f;
#pragma unroll
    for (int dt = 0; dt < 16; ++dt) {
        const LAS unsigned char* Vi = dt < 8 ? V0 : V1; const int c = dt & 7;
        f32x4 acc = (f32x4){0.f, 0.f, 0.f, 0.f};
#pragma unroll
        for (int ks = 0; ks < 4; ++ks) { const bf16x8 a = ld_tr(Vi + tr16(lane, c, ks, 0), Vi + tr16(lane, c, ks, 1)); acc = __builtin_amdgcn_mfma_f32_16x16x32_bf16(a, wf[ks], acc, 0, 0, 0); }
        const int col = g * 256 + 16 * dt + 4 * q;
        const v2u u = *(const v2u*)(H + (size_t)irow * LDH + C_U + col);
        o[dt] = (f32x4){bflo(u.x) * (acc[0] + bias), bfhi(u.x) * (acc[1] + bias), bflo(u.y) * (acc[2] + bias), bfhi(u.y) * (acc[3] + bias)};
        am = fmaxf(fmaxf(am, fmaxf(fabsf(o[dt][0]), fabsf(o[dt][1]))), fmaxf(fabsf(o[dt][2]), fabsf(o[dt][3])));
    }
    am = fmaxf(am, __shfl_xor(am, 16)); am = fmaxf(am, __shfl_xor(am, 32));
    const int sb = e8m0_of(am); const float inv = e8m0_inv(sb);
#pragma unroll
    for (int dt = 0; dt < 16; ++dt) *(unsigned*)(ycat + (size_t)irow * 6144 + 4096 + g * 256 + 16 * dt + 4 * q) = pk4_fp8(o[dt][0] * inv, o[dt][1] * inv, o[dt][2] * inv, o[dt][3] * inv);
    if (q == 0) say[sa_idx(irow, 16 + g, 24)] = (unsigned char)sb;
}

__device__ __forceinline__ unsigned off_x(unsigned j, unsigned ch) { const unsigned g = ((j >> 1) & 1u) | ((((j >> 2) ^ (j >> 3)) & 1u) << 1); return 128u * j + 16u * (ch ^ (2u * g)); }
__device__ __forceinline__ unsigned trx(unsigned lane, unsigned tp, unsigned rowbase) { return off_x(rowbase + ((lane & 15u) >> 2), 2u * tp + ((lane & 3u) >> 1)) + 8u * (lane & 1u); }
struct SmpArgs { const float* sin; float* sout; const float* a_log; const float* d_skip; int bg0; int fuse; };
__device__ __forceinline__ void ssd_chunk_unit(const bf16* xbcc, const float* dtb, int b, int h, float a, float Dk, bf16* yraw, float* sout, LAS unsigned char* lds, int tid, const SmpArgs sm) {
    const int lane = tid & 63, w = __builtin_amdgcn_readfirstlane(tid >> 6), q0 = lane >> 4, fr0 = lane & 15, g = h >> 3;
    const int I = w < 4 ? w : 11 - w;
    LAS unsigned char* Xl = lds; LAS unsigned char* Xsl = lds + 16384; LAS unsigned char* Bl = lds + 32768; LAS unsigned char* Cl = lds + 65536; LAS unsigned char* Sl = lds + 98304;
    LAS float* tab = (LAS float*)(lds + 114688);
    const int row0 = b * 2048;
    LAS unsigned char* smp = lds + 118784;
#define SMP_STAGE(jj) do { if (sm.fuse && tid < 128) { const int bg_ = sm.bg0 + 256 * (jj), t_ = tid >> 5, part_ = (tid >> 4) & 1, ch_ = tid & 15; \
        *(LAS v4u*)(smp + (t_ * 2 + part_) * 256 + ch_ * 16) = *(const v4u*)(xbcc + (size_t)(TP + 4 * (bg_ >> 3) + t_) * 6144 + (part_ ? 5120 : 4096) + (bg_ & 7) * 128 + ch_ * 8); } } while (0)
#define SMP_LOAD(cc) do { const int bg_ = sm.bg0 + 256 * ((cc) >> 2), p_ = w * 8 + (lane >> 3), ng_ = lane & 7; \
        _Pragma("unroll") for (int hh = 0; hh < 2; ++hh) { const int hs_ = (bg_ & 7) * 8 + 2 * ((cc) & 3) + hh; const f32x4* sp_ = (const f32x4*)(sm.sin + (size_t)((bg_ >> 3) * 64 + hs_) * 8192 + (size_t)p_ * 128 + ng_ * 16); \
            _Pragma("unroll") for (int k = 0; k < 4; ++k) sst[hh][k] = sp_[k]; } } while (0)
#define WG_BAR() do { LDS_WAIT(); __builtin_amdgcn_s_barrier(); asm volatile("" ::: "memory"); } while (0)
    f32x4 sst[2][4];
    v4u rx[2], rb[4], rc[4];
    f32x4 accS[4];
#pragma unroll
    for (int tp = 0; tp < 4; ++tp) accS[tp] = (f32x4){0.f, 0.f, 0.f, 0.f};
    __syncthreads();
#pragma unroll
    for (int k = 0; k < 2; ++k) *(LAS v4u*)(Sl + (tid + 512 * k) * 16) = (v4u){0u, 0u, 0u, 0u};
#define SSD_LOAD(cc) do { const bf16* base_ = xbcc + (size_t)(row0 + (cc) * 128) * 6144; \
        _Pragma("unroll") for (int k = 0; k < 2; ++k) { const int idx = (int)tq + 512 * k; rx[k] = *(const v4u*)(base_ + (size_t)(idx >> 3) * 6144 + h * 64 + (idx & 7) * 8); } \
        _Pragma("unroll") for (int k = 0; k < 4; ++k) { const int idx = (int)tq + 512 * k; rb[k] = *(const v4u*)(base_ + (size_t)(idx >> 4) * 6144 + 4096 + g * 128 + (idx & 15) * 8); \
                                                         rc[k] = *(const v4u*)(base_ + (size_t)(idx >> 4) * 6144 + 5120 + g * 128 + (idx & 15) * 8); } } while (0)
#define SSD_TABLE(cc) do { if (w == 0) { LAS float* tb_ = tab + ((cc) & 1) * 388; const float* dp_ = dtb + (size_t)(row0 + (cc) * 128) * 64 + h; \
        const float d0 = dp_[(size_t)lane * 64], d1 = dp_[(size_t)(lane + 64) * 64]; float s0 = d0 * a, s1 = d1 * a; \
        _Pragma("unroll") for (int o = 1; o < 64; o <<= 1) { const float t0 = __shfl_up(s0, o), t1 = __shfl_up(s1, o); if (lane >= o) { s0 += t0; s1 += t1; } } \
        s1 += __shfl(s0, 63); const float aend = __shfl(s1, 63); \
        tb_[lane] = s0; tb_[lane + 64] = s1; tb_[128 + lane] = d0; tb_[192 + lane] = d1; tb_[256 + lane] = __expf(aend - s0) * d0; tb_[320 + lane] = __expf(aend - s1) * d1; if (lane == 0) tb_[384] = __expf(aend); } } while (0)
#define SSD_STORE(cc) do { const LAS float* te_ = tab + ((cc) & 1) * 388 + 256; \
        _Pragma("unroll") for (int k = 0; k < 2; ++k) { const int idx = (int)tq + 512 * k, j = idx >> 3, ch = idx & 7; *(LAS v4u*)(Xl + off_x(j, ch)) = rx[k]; const float t = te_[j]; \
            v4u o; o.x = pk2(bflo(rx[k].x) * t, bfhi(rx[k].x) * t); o.y = pk2(bflo(rx[k].y) * t, bfhi(rx[k].y) * t); o.z = pk2(bflo(rx[k].z) * t, bfhi(rx[k].z) * t); o.w = pk2(bflo(rx[k].w) * t, bfhi(rx[k].w) * t); \
            *(LAS v4u*)(Xsl + off_x(j, ch)) = o; } \
        _Pragma("unroll") for (int k = 0; k < 4; ++k) { const int idx = (int)tq + 512 * k, j = idx >> 4, ch = idx & 15; *(LAS v4u*)(Bl + off_b(j, ch)) = rb[k]; *(LAS v4u*)(Cl + off_b(j, ch)) = rc[k]; } } while (0)
    unsigned tq = (unsigned)tid; asm volatile("" : "+v"(tq));
    SSD_LOAD(0); SSD_TABLE(0);
    if (sm.fuse) SMP_LOAD(0);
    __syncthreads();
    SSD_STORE(0); SMP_STAGE(0);
    __syncthreads();
    for (int c = 0; c < 16; ++c) {
        unsigned ln = (unsigned)lane; asm volatile("" : "+v"(ln), "+v"(tq)); const int q = (int)(ln >> 4), fr = (int)(ln & 15u);
        if (c + 1 < 16) SSD_TABLE(c + 1);
        const LAS float* tb = tab + (c & 1) * 388;
        bf16x8 cf[4];
        f32x4 accY[4];
        float ai, ei;
        { bf16x8 sf[4][4];
#pragma unroll
          for (int s = 0; s < 4; ++s) cf[s] = ld_row(Cl + rr16(ln, I, s));
#pragma unroll
          for (int s = 0; s < 4; ++s)
#pragma unroll
              for (int tp = 0; tp < 4; ++tp) sf[s][tp] = ld_row(Sl + rr16(ln, tp, s));
          ai = tb[16 * I + fr];
          LDS_WAIT();
          ei = __expf(ai);
#pragma unroll
          for (int tp = 0; tp < 4; ++tp) accY[tp] = (f32x4){0.f, 0.f, 0.f, 0.f};
#pragma unroll
          for (int s = 0; s < 4; ++s)
#pragma unroll
              for (int tp = 0; tp < 4; ++tp) accY[tp] = __builtin_amdgcn_mfma_f32_16x16x32_bf16(sf[s][tp], cf[s], accY[tp], 0, 0, 0);
#pragma unroll
          for (int tp = 0; tp < 4; ++tp) accY[tp] = accY[tp] * ei; }
#pragma unroll
        for (int s = 0; s < 4; ++s) if (2 * s <= I) {
            const bool two = (2 * s + 1 <= I);
            bf16x8 b0f[4], b1f[4], xt[4];
#pragma unroll
            for (int sn = 0; sn < 4; ++sn) b0f[sn] = ld_row(Bl + rr16(ln, 2 * s, sn));
            if (two) {
#pragma unroll
                for (int sn = 0; sn < 4; ++sn) b1f[sn] = ld_row(Bl + rr16(ln, 2 * s + 1, sn)); }
#pragma unroll
            for (int tp = 0; tp < 4; ++tp) xt[tp] = ld_tr(Xl + trx(ln, tp, 32 * s + 4 * q), Xl + trx(ln, tp, 32 * s + 16 + 4 * q));
            const f32x4 aj0 = *(const LAS f32x4*)(tb + 32 * s + 4 * q), dj0 = *(const LAS f32x4*)(tb + 128 + 32 * s + 4 * q);
            const f32x4 aj1 = *(const LAS f32x4*)(tb + 32 * s + 16 + 4 * q), dj1 = *(const LAS f32x4*)(tb + 128 + 32 * s + 16 + 4 * q);
            LDS_WAIT();
            f32x4 g0 = (f32x4){0.f, 0.f, 0.f, 0.f}, g1 = (f32x4){0.f, 0.f, 0.f, 0.f};
#pragma unroll
            for (int sn = 0; sn < 4; ++sn) g0 = __builtin_amdgcn_mfma_f32_16x16x32_bf16(b0f[sn], cf[sn], g0, 0, 0, 0);
            if (two) {
#pragma unroll
                for (int sn = 0; sn < 4; ++sn) g1 = __builtin_amdgcn_mfma_f32_16x16x32_bf16(b1f[sn], cf[sn], g1, 0, 0, 0); }
#pragma unroll
            for (int r = 0; r < 4; ++r) { const float v = g0[r] * __expf(ai - aj0[r]) * dj0[r]; g0[r] = (2 * s < I || 4 * q + r <= fr) ? v : 0.f; }
            if (two) {
#pragma unroll
                for (int r = 0; r < 4; ++r) { const float v = g1[r] * __expf(ai - aj1[r]) * dj1[r]; g1[r] = (2 * s + 1 < I || 4 * q + r <= fr) ? v : 0.f; } }
            v4u lw; lw.x = pk2(g0[0], g0[1]); lw.y = pk2(g0[2], g0[3]); lw.z = pk2(g1[0], g1[1]); lw.w = pk2(g1[2], g1[3]);
            const bf16x8 lf = __builtin_bit_cast(bf16x8, lw);
#pragma unroll
            for (int tp = 0; tp < 4; ++tp) accY[tp] = __builtin_amdgcn_mfma_f32_16x16x32_bf16(xt[tp], lf, accY[tp], 0, 0, 0);
        }
        { const int il = 16 * I + fr; bf16* yp = yraw + (size_t)(row0 + c * 128 + il) * 4096 + h * 64 + 4 * q;
#pragma unroll
          for (int tp = 0; tp < 4; ++tp) { const v2u xw = *(const LAS v2u*)(Xl + off_x(il, 2 * tp + (q >> 1)) + 8 * (q & 1));
              const f32x4 yv = accY[tp] + (f32x4){bflo(xw.x), bfhi(xw.x), bflo(xw.y), bfhi(xw.y)} * Dk;
              v2u o; o.x = pk2(yv[0], yv[1]); o.y = pk2(yv[2], yv[3]); *(v2u*)(yp + 16 * tp) = o; } }
        if (c + 1 < 16) SSD_LOAD(c + 1);
        { bf16x8 bt[4], xs[4][4];
#pragma unroll
          for (int ks = 0; ks < 4; ++ks) bt[ks] = ld_tr(Bl + tr16(ln, w, ks, 0), Bl + tr16(ln, w, ks, 1));
#pragma unroll
          for (int ks = 0; ks < 4; ++ks)
#pragma unroll
              for (int tp = 0; tp < 4; ++tp) xs[ks][tp] = ld_tr(Xsl + trx(ln, tp, 32 * ks + 8 * q), Xsl + trx(ln, tp, 32 * ks + 8 * q + 4));
          const float cd = tb[384];
          LDS_WAIT();
#pragma unroll
          for (int tp = 0; tp < 4; ++tp) accS[tp] = accS[tp] * cd;
#pragma unroll
          for (int ks = 0; ks < 4; ++ks)
#pragma unroll
              for (int tp = 0; tp < 4; ++tp) accS[tp] = __builtin_amdgcn_mfma_f32_16x16x32_bf16(xs[ks][tp], bt[ks], accS[tp], 0, 0, 0); }
        if (sm.fuse) {
            const int sbg = sm.bg0 + 256 * (c >> 2), sb = sbg >> 3, sg = sbg & 7, sp = w * 8 + (int)(ln >> 3), sng = (int)(ln & 7u), srow0 = TP + 4 * sb;
            float sxv[2][4], sdt[2][4];
#pragma unroll
            for (int hh = 0; hh < 2; ++hh) { const int hs_ = sg * 8 + 2 * (c & 3) + hh;
#pragma unroll
                for (int t = 0; t < 4; ++t) { sxv[hh][t] = __builtin_bit_cast(float, (unsigned)xbcc[(size_t)(srow0 + t) * 6144 + hs_ * 64 + sp] << 16); sdt[hh][t] = dtb[(size_t)(srow0 + t) * 64 + hs_]; } }
#pragma unroll
            for (int hh = 0; hh < 2; ++hh) { const int hs_ = sg * 8 + 2 * (c & 3) + hh; const float sa = -__expf(sm.a_log[hs_]), sD = sm.d_skip[hs_];
                float hst[16];
#pragma unroll
                for (int k = 0; k < 4; ++k) { hst[4 * k] = sst[hh][k][0]; hst[4 * k + 1] = sst[hh][k][1]; hst[4 * k + 2] = sst[hh][k][2]; hst[4 * k + 3] = sst[hh][k][3]; }
#pragma unroll
                for (int t = 0; t < 4; ++t) {
                    const v4u b0 = *(const LAS v4u*)(smp + (t * 2) * 256 + sng * 32), b1 = *(const LAS v4u*)(smp + (t * 2) * 256 + sng * 32 + 16);
                    const v4u c0 = *(const LAS v4u*)(smp + (t * 2 + 1) * 256 + sng * 32), c1 = *(const LAS v4u*)(smp + (t * 2 + 1) * 256 + sng * 32 + 16);
                    const unsigned bb[8] = {b0.x, b0.y, b0.z, b0.w, b1.x, b1.y, b1.z, b1.w}, cc[8] = {c0.x, c0.y, c0.z, c0.w, c1.x, c1.y, c1.z, c1.w};
                    const float dA = __expf(sdt[hh][t] * sa), xdt = sxv[hh][t] * sdt[hh][t];
                    float y = 0.f;
#pragma unroll
                    for (int i = 0; i < 8; ++i) {
                        hst[2 * i] = hst[2 * i] * dA + xdt * bflo(bb[i]); y += hst[2 * i] * bflo(cc[i]);
                        hst[2 * i + 1] = hst[2 * i + 1] * dA + xdt * bfhi(bb[i]); y += hst[2 * i + 1] * bfhi(cc[i]); }
                    y += __shfl_xor(y, 1); y += __shfl_xor(y, 2); y += __shfl_xor(y, 4);
                    if (sng == 0) yraw[(size_t)(srow0 + t) * 4096 + hs_ * 64 + sp] = (bf16)f2bf(y + sD * sxv[hh][t]);
                    asm volatile("" ::: "memory");
                }
                f32x4* so_ = (f32x4*)(sm.sout + (size_t)(sb * 64 + hs_) * 8192 + (size_t)sp * 128 + sng * 16);
#pragma unroll
                for (int k = 0; k < 4; ++k) so_[k] = (f32x4){hst[4 * k], hst[4 * k + 1], hst[4 * k + 2], hst[4 * k + 3]}; }
            if (c + 1 < 16) SMP_LOAD(c + 1);
        }
        WG_BAR();
#pragma unroll
        for (int tp = 0; tp < 4; ++tp)
#pragma unroll
            for (int r = 0; r < 4; ++r) { const unsigned p = 16 * tp + 4 * q + r, n = 16 * w + fr; *(LAS unsigned short*)(Sl + off_b(p, n >> 3) + (n & 7) * 2) = (unsigned short)f2bf(accS[tp][r]); }
        if (c + 1 < 16) SSD_STORE(c + 1);
        if ((c & 3) == 3 && c + 1 < 16) SMP_STAGE((c + 1) >> 2);
        WG_BAR();
    }
#pragma unroll
    for (int tp = 0; tp < 4; ++tp)
#pragma unroll
        for (int r = 0; r < 4; ++r) sout[(size_t)(16 * tp + 4 * q0 + r) * 128 + 16 * w + fr0] = accS[tp][r];
#undef SSD_LOAD
#undef SSD_TABLE
#undef SSD_STORE
#undef SMP_STAGE
#undef SMP_LOAD
#undef WG_BAR
}

__device__ __forceinline__ void ssd_sample_wave(const bf16* xbcc, const float* dtb, const float* sin, float* sout, bf16* yraw, const float* a_log, const float* d_skip, int wu, f32x4 (&st)[4], int wu_next, int lane) {
    const int v = wu >> 3, p = (wu & 7) * 8 + (lane >> 3), ng = lane & 7, b = v >> 6, h = v & 63, g = h >> 3;
    f32x4 nx[4];
    if (wu_next >= 0) { const float* sp = sin + (size_t)(wu_next >> 3) * 8192 + (size_t)((wu_next & 7) * 8 + (lane >> 3)) * 128 + ng * 16;
#pragma unroll
        for (int k = 0; k < 4; ++k) nx[k] = *(const f32x4*)(sp + 4 * k); }
    const float a = -__expf(a_log[h]), Dk = d_skip[h];
    const int row0 = TP + b * 4;
    float hs[16];
#pragma unroll
    for (int k = 0; k < 4; ++k) { hs[4 * k] = st[k][0]; hs[4 * k + 1] = st[k][1]; hs[4 * k + 2] = st[k][2]; hs[4 * k + 3] = st[k][3]; }
    v4u bw[4][2], cw[4][2]; float xv[4], dtv[4];
#pragma unroll
    for (int t = 0; t < 4; ++t) { const bf16* rp = xbcc + (size_t)(row0 + t) * 6144;
        bw[t][0] = *(const v4u*)(rp + 4096 + g * 128 + ng * 16); bw[t][1] = *(const v4u*)(rp + 4096 + g * 128 + ng * 16 + 8);
        cw[t][0] = *(const v4u*)(rp + 5120 + g * 128 + ng * 16); cw[t][1] = *(const v4u*)(rp + 5120 + g * 128 + ng * 16 + 8);
        xv[t] = __builtin_bit_cast(float, (unsigned)rp[h * 64 + p] << 16); dtv[t] = dtb[(size_t)(row0 + t) * 64 + h]; }
#pragma unroll
    for (int t = 0; t < 4; ++t) {
        const float dA = __expf(dtv[t] * a), xdt = xv[t] * dtv[t];
        const unsigned bb[8] = {bw[t][0].x, bw[t][0].y, bw[t][0].z, bw[t][0].w, bw[t][1].x, bw[t][1].y, bw[t][1].z, bw[t][1].w};
        const unsigned cc[8] = {cw[t][0].x, cw[t][0].y, cw[t][0].z, cw[t][0].w, cw[t][1].x, cw[t][1].y, cw[t][1].z, cw[t][1].w};
        float y = 0.f;
#pragma unroll
        for (int i = 0; i < 8; ++i) {
            hs[2 * i] = hs[2 * i] * dA + xdt * bflo(bb[i]); y += hs[2 * i] * bflo(cc[i]);
            hs[2 * i + 1] = hs[2 * i + 1] * dA + xdt * bfhi(bb[i]); y += hs[2 * i + 1] * bfhi(cc[i]); }
        y += __shfl_xor(y, 1); y += __shfl_xor(y, 2); y += __shfl_xor(y, 4);
        if (ng == 0) yraw[(size_t)(row0 + t) * 4096 + h * 64 + p] = (bf16)f2bf(y + Dk * xv[t]);
    }
    { float* sp = sout + (size_t)v * 8192 + (size_t)p * 128 + ng * 16;
#pragma unroll
      for (int k = 0; k < 4; ++k) *(f32x4*)(sp + 4 * k) = (f32x4){hs[4 * k], hs[4 * k + 1], hs[4 * k + 2], hs[4 * k + 3]}; }
    if (wu_next >= 0) {
#pragma unroll
        for (int k = 0; k < 4; ++k) st[k] = nx[k]; }
}

__device__ __forceinline__ void ssd_sample_bg(const bf16* xbcc, const float* dtb, const float* sin, float* sout, bf16* yraw, const float* a_log, const float* d_skip, int bg, int wave, int lane) {
    const int b = bg >> 3, g = bg & 7, p = wave * 8 + (lane >> 3), ng = lane & 7, row0 = TP + b * 4;
    unsigned bb[4][8], cc[4][8];
#pragma unroll
    for (int t = 0; t < 4; ++t) { const bf16* rp = xbcc + (size_t)(row0 + t) * 6144 + g * 128 + ng * 16;
        const v4u b0 = *(const v4u*)(rp + 4096), b1 = *(const v4u*)(rp + 4096 + 8), c0 = *(const v4u*)(rp + 5120), c1 = *(const v4u*)(rp + 5120 + 8);
        bb[t][0] = b0.x; bb[t][1] = b0.y; bb[t][2] = b0.z; bb[t][3] = b0.w; bb[t][4] = b1.x; bb[t][5] = b1.y; bb[t][6] = b1.z; bb[t][7] = b1.w;
        cc[t][0] = c0.x; cc[t][1] = c0.y; cc[t][2] = c0.z; cc[t][3] = c0.w; cc[t][4] = c1.x; cc[t][5] = c1.y; cc[t][6] = c1.z; cc[t][7] = c1.w; }
    const size_t soff = (size_t)p * 128 + ng * 16;
    f32x4 st[4], nx[4]; float xv[4], dtv[4], xn[4], dn[4];
#define SB_LOAD(ST, XV, DT, hh_) do { const int h_ = g * 8 + (hh_); const f32x4* sp_ = (const f32x4*)(sin + (size_t)(b * 64 + h_) * 8192 + soff); \
        _Pragma("unroll") for (int k = 0; k < 4; ++k) ST[k] = sp_[k]; \
        _Pragma("unroll") for (int t = 0; t < 4; ++t) { XV[t] = __builtin_bit_cast(float, (unsigned)xbcc[(size_t)(row0 + t) * 6144 + h_ * 64 + p] << 16); DT[t] = dtb[(size_t)(row0 + t) * 64 + h_]; } } while (0)
#define SB_STEP(ST, XV, DT, NST, NXV, NDT, hh_) do { \
        if ((hh_) < 7) SB_LOAD(NST, NXV, NDT, (hh_) + 1); \
        const int h_ = g * 8 + (hh_); const float a_ = -__expf(a_log[h_]), D_ = d_skip[h_]; \
        float hs[16]; _Pragma("unroll") for (int k = 0; k < 4; ++k) { hs[4 * k] = ST[k][0]; hs[4 * k + 1] = ST[k][1]; hs[4 * k + 2] = ST[k][2]; hs[4 * k + 3] = ST[k][3]; } \
        _Pragma("unroll") for (int t = 0; t < 4; ++t) { const float dA = __expf(DT[t] * a_), xdt = XV[t] * DT[t]; float y = 0.f; \
            _Pragma("unroll") for (int i = 0; i < 8; ++i) { hs[2 * i] = hs[2 * i] * dA + xdt * bflo(bb[t][i]); y += hs[2 * i] * bflo(cc[t][i]); hs[2 * i + 1] = hs[2 * i + 1] * dA + xdt * bfhi(bb[t][i]); y += hs[2 * i + 1] * bfhi(cc[t][i]); } \
            y += __shfl_xor(y, 1); y += __shfl_xor(y, 2); y += __shfl_xor(y, 4); \
            if (ng == 0) yraw[(size_t)(row0 + t) * 4096 + h_ * 64 + p] = (bf16)f2bf(y + D_ * XV[t]); } \
        f32x4* so_ = (f32x4*)(sout + (size_t)(b * 64 + h_) * 8192 + soff); \
        _Pragma("unroll") for (int k = 0; k < 4; ++k) so_[k] = (f32x4){hs[4 * k], hs[4 * k + 1], hs[4 * k + 2], hs[4 * k + 3]}; } while (0)
    SB_LOAD(st, xv, dtv, 0);
    for (int h2 = 0; h2 < 8; h2 += 2) { SB_STEP(st, xv, dtv, nx, xn, dn, h2); SB_STEP(nx, xn, dn, st, xv, dtv, h2 + 1); }
#undef SB_LOAD
#undef SB_STEP
}

struct P7Args { const bf16* r1b; bf16* x1lo; bf16* x1b; const float *ln_g, *ln_b, *b_rg, *b_re; const v4u* wrf; unsigned* cnt; int* grp; int* rank; float* gw; };
__device__ __forceinline__ void ln1_row(const P7Args& a, int row, int lane) {
    const bf16* rp = a.r1b + (size_t)row * 4096;
    float v[64]; float s = 0.f;
#pragma unroll
    for (int j = 0; j < 8; ++j) { const v4u w = *(const v4u*)(rp + (lane + 64 * j) * 8);
        v[8 * j] = bflo(w.x); v[8 * j + 1] = bfhi(w.x); v[8 * j + 2] = bflo(w.y); v[8 * j + 3] = bfhi(w.y); v[8 * j + 4] = bflo(w.z); v[8 * j + 5] = bfhi(w.z); v[8 * j + 6] = bflo(w.w); v[8 * j + 7] = bfhi(w.w); }
#pragma unroll
    for (int i = 0; i < 64; ++i) s += v[i];
    const float mean = wave_sum(s) * (1.f / 4096.f); float s2 = 0.f;
#pragma unroll
    for (int i = 0; i < 64; ++i) { v[i] -= mean; s2 += v[i] * v[i]; }
    const float rstd = 1.f / sqrtf(wave_sum(s2) * (1.f / 4096.f) + LN_EPS);
#pragma unroll
    for (int j = 0; j < 8; ++j) { const int c = (lane + 64 * j) * 8;
        const f32x4 g0 = *(const f32x4*)(a.ln_g + c), g1 = *(const f32x4*)(a.ln_g + c + 4), b0 = *(const f32x4*)(a.ln_b + c), b1 = *(const f32x4*)(a.ln_b + c + 4);
        f32x4 o0, o1;
#pragma unroll
        for (int i = 0; i < 4; ++i) { o0[i] = v[8 * j + i] * rstd * g0[i] + b0[i]; o1[i] = v[8 * j + 4 + i] * rstd * g1[i] + b1[i]; }
        v4u w; w.x = pk2(o0[0], o0[1]); w.y = pk2(o0[2], o0[3]); w.z = pk2(o1[0], o1[1]); w.w = pk2(o1[2], o1[3]);
        v4u l; l.x = pk2(o0[0] - bflo(w.x), o0[1] - bfhi(w.x)); l.y = pk2(o0[2] - bflo(w.y), o0[3] - bfhi(w.y)); l.z = pk2(o1[0] - bflo(w.z), o1[1] - bfhi(w.z)); l.w = pk2(o1[2] - bflo(w.w), o1[3] - bfhi(w.w));
        *(v4u*)(a.x1b + (size_t)row * 4096 + c) = w; *(v4u*)(a.x1lo + (size_t)row * 4096 + c) = l; }
}
__device__ __forceinline__ void router_tile(const P7Args& a, int row0, int nvalid, LAS float* lg, int lane) {
    const int fr = lane & 15, q = lane >> 4;
    const size_t xoff = (size_t)(row0 + (fr < nvalid ? fr : 0)) * 4096 + 8 * q;
    f32x4 acc[3];
#pragma unroll
    for (int c = 0; c < 3; ++c) acc[c] = (f32x4){0.f, 0.f, 0.f, 0.f};
#pragma unroll 2
    for (int sk = 0; sk < 128; ++sk) {
        const bf16x8 ah = __builtin_bit_cast(bf16x8, *(const v4u*)(a.x1b + xoff + 32 * sk)), al = __builtin_bit_cast(bf16x8, *(const v4u*)(a.x1lo + xoff + 32 * sk));
        const v4u* wf = a.wrf + (size_t)sk * 6 * 64 + lane;
#pragma unroll
        for (int c = 0; c < 3; ++c) { const bf16x8 wh = __builtin_bit_cast(bf16x8, wf[(2 * c) * 64]), wl = __builtin_bit_cast(bf16x8, wf[(2 * c + 1) * 64]);
            acc[c] = __builtin_amdgcn_mfma_f32_16x16x32_bf16(ah, wh, acc[c], 0, 0, 0);
            acc[c] = __builtin_amdgcn_mfma_f32_16x16x32_bf16(al, wh, acc[c], 0, 0, 0);
            acc[c] = __builtin_amdgcn_mfma_f32_16x16x32_bf16(ah, wl, acc[c], 0, 0, 0); }
    }
#pragma unroll
    for (int c = 0; c < 3; ++c)
#pragma unroll
        for (int r = 0; r < 4; ++r) lg[(4 * q + r) * 48 + 16 * c + fr] = acc[c][r];
    LDS_WAIT(); asm volatile("" ::: "memory");
    if (lane < nvalid) {
        const LAS float* L = lg + lane * 48; const int row = row0 + lane;
        float gl[8];
#pragma unroll
        for (int j = 0; j < 8; ++j) gl[j] = L[32 + j] + a.b_rg[j];
        int grp = 0; float gmax = gl[0];
#pragma unroll
        for (int j = 1; j < 8; ++j) if (gl[j] > gmax) { gmax = gl[j]; grp = j; }
        float den = 0.f;
#pragma unroll
        for (int j = 0; j < 8; ++j) den += __expf(gl[j] - gmax);
        const float pgrp = 1.f / den;
        float ev[4];
#pragma unroll
        for (int k = 0; k < 4; ++k) ev[k] = L[grp * 4 + k] + a.b_re[grp * 4 + k];
        int i1 = 0; float v1 = ev[0];
#pragma unroll
        for (int k = 1; k < 4; ++k) if (ev[k] > v1) { v1 = ev[k]; i1 = k; }
        int i2 = -1; float v2 = -3.0e38f;
#pragma unroll
        for (int k = 0; k < 4; ++k) if (k != i1 && ev[k] > v2) { v2 = ev[k]; i2 = k; }
        const float e = __expf(v2 - v1), w1 = pgrp / (1.f + e), w2 = pgrp * e / (1.f + e);
        const unsigned rk = atomicAdd(a.cnt + grp, 1u);
        a.grp[row] = grp; a.rank[row] = (int)rk;
        *(f32x4*)(a.gw + (size_t)row * 4) = (f32x4){i1 == 0 ? w1 : (i2 == 0 ? w2 : 0.f), i1 == 1 ? w1 : (i2 == 1 ? w2 : 0.f), i1 == 2 ? w1 : (i2 == 2 ? w2 : 0.f), i1 == 3 ? w1 : (i2 == 3 ? w2 : 0.f)};
    }
    LDS_WAIT(); asm volatile("" ::: "memory");
}

__device__ __forceinline__ void p8_sort(const bf16* x1b, const unsigned* cnt, const int* grp, const int* rank, const float* gw, unsigned char* xg, unsigned char* sax, int* tokmap, float* gws, int gwv, int NGW, int lane) {
    int tb[9]; tb[0] = 0;
#pragma unroll
    for (int g = 0; g < 8; ++g) tb[g + 1] = tb[g] + (int)((cnt[g] + 255u) >> 8);
    for (int row = gwv; row < T; row += NGW) {
        const int g = grp[row]; int base = 0;
#pragma unroll
        for (int k = 0; k < 8; ++k) base = (g == k) ? tb[k] : base;
        const size_t pos = (size_t)base * 256 + rank[row];
        const v4u* s = (const v4u*)(x1b + (size_t)row * 4096); v2u* d = (v2u*)(xg + pos * 4096);
        v4u w[8]; float am = 0.f;
#pragma unroll
        for (int j = 0; j < 8; ++j) w[j] = s[lane + 64 * j];
#pragma unroll
        for (int j = 0; j < 8; ++j) am = fmaxf(fmaxf(fmaxf(am, fmaxf(fabsf(bflo(w[j].x)), fabsf(bfhi(w[j].x)))), fmaxf(fabsf(bflo(w[j].y)), fabsf(bfhi(w[j].y)))),
                                                fmaxf(fmaxf(fabsf(bflo(w[j].z)), fabsf(bfhi(w[j].z))), fmaxf(fabsf(bflo(w[j].w)), fabsf(bfhi(w[j].w)))));
#pragma unroll
        for (int dd = 1; dd < 64; dd <<= 1) am = fmaxf(am, __shfl_xor(am, dd));
        const int sb = e8m0_of(am); const float inv = e8m0_inv(sb);
#pragma unroll
        for (int j = 0; j < 8; ++j) { v2u q; q.x = pk4_fp8(bflo(w[j].x) * inv, bfhi(w[j].x) * inv, bflo(w[j].y) * inv, bfhi(w[j].y) * inv); q.y = pk4_fp8(bflo(w[j].z) * inv, bfhi(w[j].z) * inv, bflo(w[j].w) * inv, bfhi(w[j].w) * inv);
            d[lane + 64 * j] = q; }
        if (lane == 0) { const int pr = (int)pos; tokmap[pos] = row; *(f32x4*)(gws + pos * 4) = *(const f32x4*)(gw + (size_t)row * 4);
            sax[(((((pr >> 8) * 2 + ((pr >> 6) & 1)) * 2 + ((pr >> 7) & 1)) * 16 + (pr & 15)) * 4) + ((pr >> 4) & 3)] = (unsigned char)sb; }
    }
    for (int idx = gwv; idx < 8 * 256; idx += NGW) {
        const int g = idx >> 8; int base = 0, n = 0, c = 0;
#pragma unroll
        for (int k = 0; k < 8; ++k) { base = (g == k) ? tb[k] : base; n = (g == k) ? tb[k + 1] - tb[k] : n; c = (g == k) ? (int)cnt[k] : c; }
        const int r = c + (idx & 255);
        if (r < n * 256) { const size_t pos = (size_t)base * 256 + r; v2u* d = (v2u*)(xg + pos * 4096);
#pragma unroll
            for (int j = 0; j < 8; ++j) d[lane + 64 * j] = (v2u){0u, 0u};
            if (lane == 0) { const int pr = (int)pos; tokmap[pos] = -1; *(f32x4*)(gws + pos * 4) = (f32x4){0.f, 0.f, 0.f, 0.f};
                sax[(((((pr >> 8) * 2 + ((pr >> 6) & 1)) * 2 + ((pr >> 7) & 1)) * 16 + (pr & 15)) * 4) + ((pr >> 4) & 3)] = (unsigned char)127; } }
    }
}

__device__ __forceinline__ void ln2_row(const bf16* r2, const float* g, const float* b, float* out, int row, int lane) {
    const bf16* rp = r2 + (size_t)row * 4096;
    float v[64]; float s = 0.f;
#pragma unroll
    for (int j = 0; j < 8; ++j) { const v4u w = *(const v4u*)(rp + (lane + 64 * j) * 8);
        v[8 * j] = bflo(w.x); v[8 * j + 1] = bfhi(w.x); v[8 * j + 2] = bflo(w.y); v[8 * j + 3] = bfhi(w.y); v[8 * j + 4] = bflo(w.z); v[8 * j + 5] = bfhi(w.z); v[8 * j + 6] = bflo(w.w); v[8 * j + 7] = bfhi(w.w); }
#pragma unroll
    for (int i = 0; i < 64; ++i) s += v[i];
    const float mean = wave_sum(s) * (1.f / 4096.f); float s2 = 0.f;
#pragma unroll
    for (int i = 0; i < 64; ++i) { v[i] -= mean; s2 += v[i] * v[i]; }
    const float rstd = 1.f / sqrtf(wave_sum(s2) * (1.f / 4096.f) + LN_EPS);
#pragma unroll
    for (int j = 0; j < 8; ++j) { const int c = (lane + 64 * j) * 8;
        const f32x4 g0 = *(const f32x4*)(g + c), g1 = *(const f32x4*)(g + c + 4), b0 = *(const f32x4*)(b + c), b1 = *(const f32x4*)(b + c + 4);
        f32x4 o0, o1;
#pragma unroll
        for (int i = 0; i < 4; ++i) { o0[i] = v[8 * j + i] * rstd * g0[i] + b0[i]; o1[i] = v[8 * j + 4 + i] * rstd * g1[i] + b1[i]; }
        *(f32x4*)(out + (size_t)row * 4096 + c) = o0; *(f32x4*)(out + (size_t)row * 4096 + c + 4) = o1; }
}
constexpr int NPH = 12;

struct Args { const float* in[29]; float* out; unsigned char* ws; int ph_lo, ph_hi; };
constexpr size_t O_Y = 0, O_STP = 35651584, O_CVP = 37748736, O_STS = 37822464, O_CVS = 104931328, O_VS = 107290624, O_END = 108339200;

__global__ void __launch_bounds__(NTHR, 2) mk_fwd(Args args) {
    extern __shared__ __attribute__((aligned(16))) unsigned char lds_raw[];
    LAS unsigned char* lds = (LAS unsigned char*)lds_raw;
    volatile LAS unsigned* MISC = (volatile LAS unsigned*)(lds + MISC_OFF);
    const int tid = threadIdx.x, lane = tid & 63, wave = __builtin_amdgcn_readfirstlane(tid >> 6);
    const int G = gridDim.x, bx = blockIdx.x, gw = bx * NWAVES + wave, NGW = G * NWAVES;
    unsigned char* ws = args.ws;
    unsigned* ctl = (unsigned*)(ws + WS_CTL);
    const int lo = args.ph_lo, hi = args.ph_hi;
    for (int u = tid; u < (LDS_BYTES - RING_BYTES) / 4; u += NTHR) ((LAS unsigned*)(lds + RING_BYTES))[u] = 0u;
    __syncthreads();
    XcdBarrier bar; bar.bar = ctl + CW_BAR; bar.x = 0; bar.st = nullptr;
    if (hi - lo > 1) bar = xcd_barrier_post(ctl + CW_BAR, MISC + 8);
#ifndef PH_MASK
#define PH_MASK 0xFFF
#endif
#define IN(k) (((PH_MASK >> (k)) & 1) && lo <= (k) && (k) < hi)
#define SEAM(k) do { if (IN(k) && IN((k) + 1)) xcd_barrier(bar); } while (0)

    bf16* Wt_in = (bf16*)(ws + WS_WIN); bf16* Wt_p = (bf16*)(ws + WS_WP); bf16* Wt_out = (bf16*)(ws + WS_WOUT); bf16* Wt_gu = (bf16*)(ws + WS_WGU); bf16* Wt_dn = (bf16*)(ws + WS_WDN);
    bf16* xb = (bf16*)(ws + WS_XB); bf16* H = (bf16*)(ws + WS_H); float* dtb = (float*)(ws + WS_DT); bf16* yraw = (bf16*)(ws + WS_YRAW); bf16* ycat = (bf16*)(ws + WS_YCAT);
    bf16* mrg = (bf16*)(ws + WS_MRG); bf16* r1b = (bf16*)(ws + WS_R1); bf16* xbcc = (bf16*)(ws + WS_R1); bf16* r2b = (bf16*)(ws + WS_YRAW); bf16* x1lo = (bf16*)(ws + WS_YRAW);
    unsigned char* xg = ws + WS_XG; unsigned char* Hm = ws + WS_HM;
    int* t_grp = (int*)(ws + WS_SMALL + SM_GRP); int* t_rank = (int*)(ws + WS_SMALL + SM_RANK); float* t_gw = (float*)(ws + WS_SMALL + SM_GW);
    int* t_tok = (int*)(ws + WS_SMALL + SM_TOK); float* t_gws = (float*)(ws + WS_SMALL + SM_GWS);
    unsigned* cnt = ctl + CW_CNT;
    float* out = args.out;

    const bool tailconv = (G == 256);
    constexpr int MOE_ITEMS = 3 * 32 * 512, MOE_SPLIT = 30720;
    if (IN(0)) {
        P0Args a{args.in[4], args.in[15], args.in[16], args.in[17], args.in[24], args.in[25], args.in[26], args.in[0], args.in[1], Wt_in, Wt_p, Wt_out, Wt_gu, Wt_dn, xb, args.in[20], args.in[22], (v4u*)(ws + WS_WRF), ws + WS_X8, ws + WS_W8, ws + WS_SB8, ws + WS_SA8, ws + WS_WGU, ws + WS_WDN, ws + WS_SBGU, ws + WS_SBDN, ws + WS_WOUT, ws + WS_WOUT + 16 * MiB, ws + WS_WP, ws + WS_WP + 24 * MiB};
        for (int rep = 0; rep < REP_P0; ++rep) p0_convert(a, lds, gw, NGW, wave, lane, !tailconv);
    }
    SEAM(0);
    if (IN(1)) {
        pg8::EpiIn E{H, dtb, args.in[7], (unsigned char*)(ws + WS_G8)};
        { pg8::Gemm g{xb, Wt_in, T, 22784, 4096}; pg8::SelOrder S; S.init(T, G, bx, 0);
          pg8::gemm_phase<pg8::EpiIn, pg8::SelOrder, true, true, 0>(lds, g, S, E); }
        { pg8::Gemm g{(const bf16*)(ws + WS_X8), (const bf16*)(ws + WS_W8), T, 22784, 2048, (const unsigned*)(ws + WS_SA8), (const unsigned*)(ws + WS_SB8)}; pg8::SelOrder S; S.init(T, G, bx, 1);
          pg8::gemm_phase<pg8::EpiIn, pg8::SelOrder, true, true, 1>(lds, g, S, E); }
    }
    SEAM(1);
    if (IN(2)) for (int rep = 0; rep < REP_P2; ++rep) p2_conv(H, args.in[3], args.in[5], args.in[6], xbcc, out + O_CVP, out + O_CVS, (size_t)bx * NTHR + tid, (size_t)G * NTHR);
    SEAM(2);
    if (IN(3)) {
        { const int u = bx, b = u >> 6, h = u & 63;
          const SmpArgs sm{args.in[2], out + O_STS, args.in[8], args.in[9], bx, 1};
          ssd_chunk_unit(xbcc, dtb, b, h, -__expf(args.in[8][h]), args.in[9][h], yraw, out + O_STP + (size_t)u * 8192, lds, tid, sm); }
        for (int row = gw; row < T; row += NGW) vln_row(H, args.in[11], args.in[12], out + O_VS, row, lane);
    }
    SEAM(3);
    if (IN(4)) {
        for (int rep = 0; rep < REP_P4; ++rep) {
        unsigned char* ycat8 = ws + WS_YCAT; unsigned char* say = ws + WS_YCAT + 60 * MiB;
        for (int row = gw; row < T; row += NGW) ssdnorm_row(yraw, H, args.in[10], ycat8, say, row, lane);
        for (int u = bx; u < 512; u += G) sgu_unit(H, args.in[13], args.in[14], ycat8, say, (u >> 3) * 128, u & 7, lds, tid);
        for (int it = gw; it < (T - TP) * 4; it += NGW) sgu_item(H, args.in[13], args.in[14], ycat8, say, TP + (it >> 2), it & 3, lane); }
    }
    SEAM(4);
    if (IN(5)) {
        pg8::Gemm g{(const bf16*)(ws + WS_YCAT), (const bf16*)(ws + WS_WP), T, 4096, 3072, (const unsigned*)(ws + WS_YCAT + 60 * MiB), (const unsigned*)(ws + WS_WP + 24 * MiB)}; pg8::StaticOrder S; S.init(T, 4096, G, bx);
        pg8::EpiMerge E{(const unsigned char*)(ws + WS_G8), ws + WS_MRG, 32, (LAS float*)(lds + RING_BYTES), (unsigned*)(ws + WS_MRG + 40 * MiB)};
        pg8::gemm_phase<pg8::EpiMerge, pg8::StaticOrder, true, true, 3>(lds, g, S, E);
        if (tailconv && bx >= 32) { P0Args a{args.in[4], args.in[15], args.in[16], args.in[17], args.in[24], args.in[25], args.in[26], args.in[0], args.in[1], Wt_in, Wt_p, Wt_out, Wt_gu, Wt_dn, xb, args.in[20], args.in[22], (v4u*)(ws + WS_WRF), nullptr, nullptr, nullptr, nullptr, ws + WS_WGU, ws + WS_WDN, ws + WS_SBGU, ws + WS_SBDN, ws + WS_WOUT, ws + WS_WOUT + 16 * MiB, ws + WS_WP, ws + WS_WP + 24 * MiB};
            conv_wout(a, lds, (bx - 32) * NWAVES + wave, 224 * NWAVES, wave, lane);
            conv_moe(a, lds, 0, MOE_SPLIT, (bx - 32) * NWAVES + wave, 224 * NWAVES, wave, lane); }
    }
    SEAM(5);
    if (IN(6)) {
        pg8::Gemm g{(const bf16*)(ws + WS_MRG), (const bf16*)(ws + WS_WOUT), T, 4096, 2048, (const unsigned*)(ws + WS_MRG + 40 * MiB), (const unsigned*)(ws + WS_WOUT + 16 * MiB)}; pg8::StaticOrder S; S.init(T, 4096, G, bx);
        pg8::EpiRes E{xb, r1b};
        pg8::gemm_phase<pg8::EpiRes, pg8::StaticOrder, true, true, 3>(lds, g, S, E);
        if (tailconv && bx >= 32) { P0Args a{args.in[4], args.in[15], args.in[16], args.in[17], args.in[24], args.in[25], args.in[26], args.in[0], args.in[1], Wt_in, Wt_p, Wt_out, Wt_gu, Wt_dn, xb, args.in[20], args.in[22], (v4u*)(ws + WS_WRF), nullptr, nullptr, nullptr, nullptr, ws + WS_WGU, ws + WS_WDN, ws + WS_SBGU, ws + WS_SBDN, ws + WS_WOUT, ws + WS_WOUT + 16 * MiB, ws + WS_WP, ws + WS_WP + 24 * MiB};
            conv_moe(a, lds, MOE_SPLIT, MOE_ITEMS, (bx - 32) * NWAVES + wave, 224 * NWAVES, wave, lane); }
    }
    SEAM(6);
    if (IN(7)) {
        P7Args a{r1b, x1lo, xb, args.in[18], args.in[19], args.in[21], args.in[23], (const v4u*)(ws + WS_WRF), cnt, t_grp, t_rank, t_gw};
        for (int blk = bx; blk < 256; blk += G) {
            const int rb0 = blk * 34;
            for (int r = wave; r < 34; r += NWAVES) ln1_row(a, rb0 + r, lane);
            __syncthreads();
            if (wave < 3) router_tile(a, rb0 + 16 * wave, wave < 2 ? 16 : 2, (LAS float*)(lds + wave * 4096), lane);
            __syncthreads();
        }
    }
    SEAM(7);
    if (IN(8)) p8_sort(xb, cnt, t_grp, t_rank, t_gw, xg, ws + WS_SAXG, t_tok, t_gws, gw, NGW, lane);
    SEAM(8);
    if (IN(9)) {
        pg8::Gemm g{(const bf16*)xg, (const bf16*)(ws + WS_WGU), XG_ROWS, 8 * 4096, 2048, (const unsigned*)(ws + WS_SAXG), (const unsigned*)(ws + WS_SBGU)}; pg8::MoeOrder S; S.init(cnt, G, bx);
        pg8::EpiGU E{t_gws, Hm};
        for (int rep = 0; rep < REP_P9; ++rep) pg8::gemm_phase<pg8::EpiGU, pg8::MoeOrder, true, true, 1>(lds, g, S, E);
    }
    SEAM(9);
    if (IN(10)) {
        pg8::Gemm g{(const bf16*)Hm, (const bf16*)(ws + WS_WDN), XG_ROWS, 8 * 4096, 1024, nullptr, (const unsigned*)(ws + WS_SBDN)}; pg8::MoeOrder S; S.init(cnt, G, bx);
        pg8::EpiDown E{t_tok, xb, r2b};
        for (int rep = 0; rep < REP_P10; ++rep) pg8::gemm_phase<pg8::EpiDown, pg8::MoeOrder, true, true, 2>(lds, g, S, E);
    }
    SEAM(10);
    if (IN(11)) for (int rep = 0; rep < REP_P11; ++rep) { for (int row = gw; row < T; row += NGW) ln2_row(r2b, args.in[27], args.in[28], out + O_Y, row, lane); }
#undef IN
#undef SEAM
}

#ifndef MK_ONE_LAUNCH
#define MK_ONE_LAUNCH 1
#endif
extern "C" void kernel_launch(void* const* d_in, const int* in_sizes, int n_in, void* d_out, int out_size, void* d_ws, size_t ws_size, hipStream_t stream) {
    static int grid = 0;
    if (grid == 0) {
        if (n_in != 29 || (size_t)out_size != O_END || ws_size < WS_END) { fprintf(stderr, "kernel_launch: unexpected shapes (n_in %d out %d ws %zu need %zu); nothing launched\n", n_in, out_size, ws_size, (size_t)WS_END); grid = -1; return; }
        int dev = 0, cus = 0, per_cu = 0;
        if (hipGetDevice(&dev) != hipSuccess || hipDeviceGetAttribute(&cus, hipDeviceAttributeMultiprocessorCount, dev) != hipSuccess) { grid = -1; return; }
        if (hipFuncSetAttribute((const void*)mk_fwd, hipFuncAttributeMaxDynamicSharedMemorySize, LDS_BYTES) != hipSuccess) { fprintf(stderr, "kernel_launch: hipFuncSetAttribute failed\n"); grid = -1; return; }
        if (hipOccupancyMaxActiveBlocksPerMultiprocessor(&per_cu, (const void*)mk_fwd, NTHR, LDS_BYTES) != hipSuccess || per_cu < 1) { fprintf(stderr, "kernel_launch: occupancy query says %d\n", per_cu); }
        (void)hipGetLastError();
        grid = cus;
        if (grid != 256) { fprintf(stderr, "kernel_launch: built for a 256-CU device (got %d CUs); nothing launched\n", cus); grid = -1; return; }
    }
    if (grid < 0) return;
    if (hipMemsetAsync((char*)d_ws + WS_CTL, 0, CTL_ZERO_BYTES, stream) != hipSuccess) return;
    Args a{};
    for (int i = 0; i < 29; ++i) a.in[i] = (const float*)d_in[i];
    a.out = (float*)d_out; a.ws = (unsigned char*)d_ws;
#if MK_ONE_LAUNCH
    a.ph_lo = 0; a.ph_hi = NPH;
    hipLaunchKernelGGL(mk_fwd, dim3(grid), dim3(NTHR), LDS_BYTES, stream, a);
#else
    for (int k = 0; k < NPH; ++k) { a.ph_lo = k; a.ph_hi = k + 1; hipLaunchKernelGGL(mk_fwd, dim3(grid), dim3(NTHR), LDS_BYTES, stream, a); }
#endif
}
```

```cpp
#include <hip/hip_runtime.h>
#include <cstdio>
#include <cstdint>
namespace pg8 {
#define PG8_LAS __attribute__((address_space(3)))
typedef unsigned short bf16_t;
typedef short bf16x8 __attribute__((ext_vector_type(8)));
typedef float f32x4 __attribute__((ext_vector_type(4)));
typedef unsigned u32x4 __attribute__((ext_vector_type(4)));
typedef unsigned u32x2_f8 __attribute__((ext_vector_type(2)));
constexpr int BM = 256, BK = 64, HALF = 128, HTB = HALF * BK * 2  , STAGE_BYTES = 8 * HTB, NXCD = 8, WGM = 8;

__host__ __device__ __forceinline__ int lds_byte(int r, int c) { const int st = (r >> 4) * 2 + (c >> 5), rr = r & 15, cc = c & 31, ob = rr * 64 + cc * 2; return st * 1024 + (ob ^ (((ob >> 9) & 1) << 5)); }
__host__ __device__ __forceinline__ void stage_rc(int b, int& R, int& C) { const int st = b / 1024, sb = b % 1024, swz = sb ^ (((sb >> 9) & 1) << 5); R = (st >> 1) * 16 + swz / 64; C = (st & 1) * 32 + (swz % 64) / 2; }
__host__ __device__ __forceinline__ int perm32(int rho) { const int n = rho >> 4, i = rho & 15; return 8 * (i >> 2) + 4 * n + (i & 3); }

struct Unit { int pm, pn; };
struct Gemm { const bf16_t* A; const bf16_t* Bt; int M, N, K; const unsigned* sA = nullptr; const unsigned* sB = nullptr; };

struct StaticOrder {
    int nM, nN, nwg, G, c;
    __host__ __device__ void init(int M, int N, int G_, int c_) { nM = M / BM; nN = N / BM; nwg = nM * nN; G = G_; c = c_; }
    __host__ __device__ bool next(int i, Unit& u) const {
        const long L = (long)i * G + c; if (L >= nwg) return false;
        int wgid = (int)L; { const int q = nwg / NXCD, r = nwg % NXCD, xcd = wgid % NXCD, off = wgid / NXCD; wgid = (xcd < r ? xcd * (q + 1) : r * (q + 1) + (xcd - r) * q) + off; }
        const int nig = WGM * nN, gid = wgid / nig, fm = gid * WGM, gsz = (nM - fm) < WGM ? (nM - fm) : WGM;
        u.pm = fm + ((wgid % nig) % gsz); u.pn = (wgid % nig) / gsz; return true;
    }
    __device__ __forceinline__ void a_ready(const Unit&) const {}
    __device__ __forceinline__ void done(const Unit&) const {}
};

struct SelOrder {
    StaticOrder S; int kind, nrect, G, c;
    __host__ __device__ void init(int M, int G_, int c_, int kind_) { kind = kind_; G = G_; c = c_; S.init(M, (kind_ ? 56 : 25) * BM, G_, c_); nrect = S.nwg; }
    __host__ __device__ bool next(int i, Unit& u) const {
        const int L = i * G + c;
        if (L < nrect) { S.next(i, u); const int j = u.pn; u.pn = kind ? (j < 16 ? j : (j < 24 ? j + 24 : j + 32)) : (j < 24 ? j + 16 : 88); return true; }
        const int e = L - nrect; if (e >= (kind ? 256 : 16)) return false;
        u.pm = kind ? (e >> 3) : 32 + (e >> 3); u.pn = 48 + (e & 7); return true;
    }
    __device__ __forceinline__ void a_ready(const Unit&) const {}
    __device__ __forceinline__ void done(const Unit&) const {}
};
typedef float f32x2_cv __attribute__((ext_vector_type(2))); typedef __bf16 bf16x2_cv __attribute__((ext_vector_type(2)));
__device__ __forceinline__ unsigned cvt_pk_bf16(float lo, float hi) { const f32x2_cv v = {lo, hi}; const bf16x2_cv b = __builtin_convertvector(v, bf16x2_cv); return __builtin_bit_cast(unsigned, b); }
__device__ __forceinline__ int e8m0_of(float am) { const int eb = (int)((__builtin_bit_cast(unsigned, am) >> 23) & 0xffu) - 7; return eb < 1 ? 1 : eb; }
__device__ __forceinline__ float e8m0_inv(int byte) { return __builtin_bit_cast(float, (unsigned)(254 - byte) << 23); }
__device__ __forceinline__ unsigned pk4_fp8(float a, float b, float c, float d) { int w = __builtin_amdgcn_cvt_pk_fp8_f32(a, b, 0, false); w = __builtin_amdgcn_cvt_pk_fp8_f32(c, d, w, true); return (unsigned)w; }
constexpr int T_ROWS = 8704, T_PROMPT = 8192, LDH = 22784;
constexpr int C_Z = 0, C_XBC = 4096, C_U = 10240, C_V = 12288, C_G1 = 14336, C_G2 = 18432, C_DT = 22528;
constexpr float ALPHA_DN = 1.189207115002721f;

__device__ __forceinline__ float sigm(float a) { return __builtin_amdgcn_rcpf(1.0f + __builtin_amdgcn_exp2f(-1.4426950408889634f * a)); }
__device__ __forceinline__ float bflo(unsigned w) { return __builtin_bit_cast(float, w << 16); }
__device__ __forceinline__ float bfhi(unsigned w) { return __builtin_bit_cast(float, w & 0xffff0000u); }

struct EpiIn {
    static constexpr bool PERM = true, AFTER_DRAIN = false, MIDK = false;
    bf16_t* H; float* dtb; const float* dt_bias; unsigned char* G8;
    __device__ __forceinline__ void operator()(const f32x4 (&acc)[2][2][4][2], const Unit& u, int wr, int wc, int fr, int fq) const {
        const int pn = u.pn, row0 = u.pm * BM + wr * 64 + fr;
        if (pn >= 88) {
            if (wc < 2) {
                const int c0 = wc * 32 + 8 * fq;
                const f32x4 b0 = *(const f32x4*)(dt_bias + c0), b1 = *(const f32x4*)(dt_bias + c0 + 4);
#pragma unroll
                for (int ai = 0; ai < 2; ++ai)
#pragma unroll
                    for (int m = 0; m < 4; ++m) {
                        f32x4 v0 = acc[ai][0][m][0] + b0, v1 = acc[ai][0][m][1] + b1;
#pragma unroll
                        for (int j = 0; j < 4; ++j) { v0[j] = v0[j] > 20.f ? v0[j] : log1pf(expf(v0[j])); v1[j] = v1[j] > 20.f ? v1[j] : log1pf(expf(v1[j])); }
                        float* o = dtb + (size_t)(row0 + ai * HALF + m * 16) * 64 + c0;
                        *(f32x4*)o = v0; *(f32x4*)(o + 4) = v1;
                    }
            }
            return;
        }
        if (pn >= 56) {
            unsigned char* gp = G8 + (size_t)row0 * 8192 + (size_t)((pn - 56) >> 4) * 4096 + ((pn - 56) & 15) * 256 + (wc * 4 + fq) * 16;
#pragma unroll
            for (int ai = 0; ai < 2; ++ai)
#pragma unroll
                for (int m = 0; m < 4; ++m) { u32x4 w;
#pragma unroll
                    for (int bj = 0; bj < 2; ++bj)
#pragma unroll
                        for (int n = 0; n < 2; ++n) { unsigned d = 0u;
#pragma unroll
                            for (int j = 0; j < 4; ++j) d = __builtin_amdgcn_cvt_pk_u8_f32(fmaxf(sigm(acc[ai][bj][m][n][j]) * 255.0f, 1.0f), j, d);
                            w[bj * 2 + n] = d; }
                    *(u32x4*)(gp + (size_t)(ai * HALF + m * 16) * 8192) = w; }
            return;
        }
        const int mode = pn < 16 ? 1 : (pn < 40 ? 0 : 2);
        const int col0 = pn * BM + wc * 32 + 8 * fq;
#define EPIIN_BODY(ACT) do { _Pragma("unroll") for (int ai = 0; ai < 2; ++ai) _Pragma("unroll") for (int m = 0; m < 4; ++m) { bf16_t* rowp = H + (size_t)(row0 + ai * HALF + m * 16) * LDH + col0; \
            _Pragma("unroll") for (int bj = 0; bj < 2; ++bj) { f32x4 v0 = acc[ai][bj][m][0], v1 = acc[ai][bj][m][1]; \
                _Pragma("unroll") for (int j = 0; j < 4; ++j) { const float x0 = v0[j], x1 = v1[j]; v0[j] = ACT(x0); v1[j] = ACT(x1); } \
                u32x4 w; w.x = cvt_pk_bf16(v0[0], v0[1]); w.y = cvt_pk_bf16(v0[2], v0[3]); w.z = cvt_pk_bf16(v1[0], v1[1]); w.w = cvt_pk_bf16(v1[2], v1[3]); \
                *(u32x4*)(rowp + bj * HALF) = w; } } } while (0)
#define ACT_ID(x) (x)
#define ACT_SILU(x) ((x) * sigm(x))
#define ACT_GELU(x) ((x) * sigm((x) * (1.5957691216057308f + 0.07135481627260025f * (x) * (x))))
#define ACT_SIGM(x) sigm(x)
        if (mode == 0) EPIIN_BODY(ACT_ID); else if (mode == 1) EPIIN_BODY(ACT_SILU); else EPIIN_BODY(ACT_GELU);
#undef EPIIN_BODY
#undef ACT_ID
#undef ACT_SILU
#undef ACT_GELU
#undef ACT_SIGM
    }
};

struct EpiMerge {
    static constexpr bool PERM = true, AFTER_DRAIN = false, MIDK = true;
    const unsigned char* G8; unsigned char* O; int tsplit; PG8_LAS float* X; unsigned* SA;
    __device__ __forceinline__ void mid(f32x4 (&acc)[2][2][4][2], const Unit& u, int wr, int wc, int fr, int fq) const {
        unsigned rb = (unsigned)(u.pm * BM + wr * 64 + fr) * 8192u + (unsigned)(u.pn * 256 + (wc * 4 + fq) * 16);
        asm volatile("" : "+v"(rb));
#pragma unroll
        for (int ai = 0; ai < 2; ++ai)
#pragma unroll
            for (int m = 0; m < 4; ++m) { const unsigned ro = rb + (unsigned)((ai * HALF + m * 16) * 8192);
                const u32x4 a = *(const u32x4*)(G8 + ro), b = *(const u32x4*)(G8 + ro + 4096);
#pragma unroll
                for (int bj = 0; bj < 2; ++bj)
#pragma unroll
                    for (int n = 0; n < 2; ++n) { const unsigned qa = a[bj * 2 + n], qb = b[bj * 2 + n]; f32x4 r;
                        r[0] = (float)(qa & 0xffu) * __builtin_amdgcn_rcpf((float)(qb & 0xffu)); r[1] = (float)((qa >> 8) & 0xffu) * __builtin_amdgcn_rcpf((float)((qb >> 8) & 0xffu));
                        r[2] = (float)((qa >> 16) & 0xffu) * __builtin_amdgcn_rcpf((float)((qb >> 16) & 0xffu)); r[3] = (float)(qa >> 24) * __builtin_amdgcn_rcpf((float)(qb >> 24));
                        acc[ai][bj][m][n] *= r; }
                asm volatile("" ::: "memory"); }
    }
    __device__ __forceinline__ void operator()(f32x4 (&acc)[2][2][4][2], const Unit& u, int wr, int wc, int fr, int fq) const {
        unsigned rrow = (unsigned)(u.pm * BM + wr * 64 + fr), cc = (unsigned)(u.pn * BM + wc * 32 + 8 * fq), gg = (unsigned)(u.pn * 256 + (wc * 4 + fq) * 16);
        asm volatile("" : "+v"(rrow), "+v"(cc), "+v"(gg));
        constexpr float K255 = 1.0f / 255.0f; float rmax[8];
#pragma unroll
        for (int ai = 0; ai < 2; ++ai)
#pragma unroll
            for (int m = 0; m < 4; ++m) { const unsigned row = rrow + (unsigned)(ai * HALF + m * 16);
                const u32x4 b = *(const u32x4*)(G8 + row * 8192u + 4096u + gg); float am = 0.f;
#pragma unroll
                for (int bj = 0; bj < 2; ++bj)
#pragma unroll
                    for (int n = 0; n < 2; ++n) { const unsigned q = b[bj * 2 + n];
                        const f32x4 gt = {(float)(q & 0xffu) * K255, (float)((q >> 8) & 0xffu) * K255, (float)((q >> 16) & 0xffu) * K255, (float)(q >> 24) * K255};
                        acc[ai][bj][m][n] *= gt; const f32x4 v = acc[ai][bj][m][n];
                        am = fmaxf(fmaxf(am, fmaxf(fabsf(v[0]), fabsf(v[1]))), fmaxf(fabsf(v[2]), fabsf(v[3]))); }
                am = fmaxf(am, __shfl_xor(am, 16)); am = fmaxf(am, __shfl_xor(am, 32)); rmax[ai * 4 + m] = am;
                asm volatile("" ::: "memory"); }
        const int lr = wr * 64 + (int)(rrow & 15u);
        if (fq == 0) {
#pragma unroll
            for (int i = 0; i < 8; ++i) X[(lr + (i >> 2) * HALF + (i & 3) * 16) * 4 + wc] = rmax[i]; }
        asm volatile("s_waitcnt lgkmcnt(0)" ::: "memory"); __builtin_amdgcn_s_barrier(); asm volatile("" ::: "memory");
        unsigned sw[2] = {0u, 0u};
#pragma unroll
        for (int ai = 0; ai < 2; ++ai)
#pragma unroll
            for (int m = 0; m < 4; ++m) { const unsigned row = rrow + (unsigned)(ai * HALF + m * 16);
                const f32x4 x4 = *(const PG8_LAS f32x4*)(X + (lr + ai * HALF + m * 16) * 4);
                const int sb = e8m0_of(fmaxf(fmaxf(x4[0], x4[1]), fmaxf(x4[2], x4[3]))); const float inv = e8m0_inv(sb); sw[ai] |= (unsigned)sb << (8 * m);
#pragma unroll
                for (int bj = 0; bj < 2; ++bj) { const f32x4 v0 = acc[ai][bj][m][0] * inv, v1 = acc[ai][bj][m][1] * inv;
                    *(u32x2_f8*)(O + (size_t)row * 4096 + cc + bj * HALF) = (u32x2_f8){pk4_fp8(v0[0], v0[1], v0[2], v0[3]), pk4_fp8(v1[0], v1[1], v1[2], v1[3])}; } }
        if (wc == 0 && fq == 0) { unsigned* sp = SA + ((size_t)(u.pm * 16 + u.pn) * 2 + wr) * 32 + (rrow & 15u); sp[0] = sw[0]; sp[16] = sw[1]; }
    }
};

struct EpiRes {
    static constexpr bool PERM = true, AFTER_DRAIN = false, MIDK = false;
    const bf16_t* xb; bf16_t* R;
    __device__ __forceinline__ void operator()(const f32x4 (&acc)[2][2][4][2], const Unit& u, int wr, int wc, int fr, int fq) const {
        const int row0 = u.pm * BM + wr * 64 + fr, col0 = u.pn * BM + wc * 32 + 8 * fq;
#pragma unroll
        for (int ai = 0; ai < 2; ++ai)
#pragma unroll
            for (int m = 0; m < 4; ++m) { const size_t off = (size_t)(row0 + ai * HALF + m * 16) * 4096 + col0;
#pragma unroll
                for (int bj = 0; bj < 2; ++bj) { const u32x4 x = *(const u32x4*)(xb + off + bj * HALF);
                    const f32x4 v0 = (f32x4){bflo(x.x), bfhi(x.x), bflo(x.y), bfhi(x.y)} * ALPHA_DN + acc[ai][bj][m][0], v1 = (f32x4){bflo(x.z), bfhi(x.z), bflo(x.w), bfhi(x.w)} * ALPHA_DN + acc[ai][bj][m][1];
                    u32x4 w; w.x = cvt_pk_bf16(v0[0], v0[1]); w.y = cvt_pk_bf16(v0[2], v0[3]); w.z = cvt_pk_bf16(v1[0], v1[1]); w.w = cvt_pk_bf16(v1[2], v1[3]);
                    *(u32x4*)(R + off + bj * HALF) = w; } }
    }
};

struct EpiGU {
    static constexpr bool PERM = true, AFTER_DRAIN = false, MIDK = false;
    const float* gws; unsigned char* Hm;
    __device__ __forceinline__ void operator()(const f32x4 (&acc)[2][2][4][2], const Unit& u, int wr, int wc, int fr, int fq) const {
        const int pnl = u.pn & 15, el = pnl >> 2, row0 = u.pm * BM + wr * 64 + fr, col0 = pnl * 128 + wc * 32 + 8 * fq;
#pragma unroll
        for (int ai = 0; ai < 2; ++ai)
#pragma unroll
            for (int m = 0; m < 4; ++m) { const size_t row = (size_t)(row0 + ai * HALF + m * 16); const float gw = gws[row * 4 + el];
                f32x4 v0, v1;
#pragma unroll
                for (int j = 0; j < 4; ++j) { const float g0 = acc[ai][0][m][0][j], g1 = acc[ai][0][m][1][j];
                    v0[j] = g0 * sigm(g0) * acc[ai][1][m][0][j] * gw; v1[j] = g1 * sigm(g1) * acc[ai][1][m][1][j] * gw; }
                int w0 = __builtin_amdgcn_cvt_pk_bf8_f32(v0[0], v0[1], 0, false); w0 = __builtin_amdgcn_cvt_pk_bf8_f32(v0[2], v0[3], w0, true);
                int w1 = __builtin_amdgcn_cvt_pk_bf8_f32(v1[0], v1[1], 0, false); w1 = __builtin_amdgcn_cvt_pk_bf8_f32(v1[2], v1[3], w1, true);
                __hip_atomic_store((__attribute__((address_space(1))) unsigned long long*)(Hm + row * 2048 + col0), ((unsigned long long)(unsigned)w1 << 32) | (unsigned)w0, __ATOMIC_RELAXED, __HIP_MEMORY_SCOPE_AGENT); }
    }
};

struct EpiDown {
    static constexpr bool PERM = true, AFTER_DRAIN = false, MIDK = false;
    const int* tokmap; const bf16_t* x1; bf16_t* R2;
    __device__ __forceinline__ void operator()(const f32x4 (&acc)[2][2][4][2], const Unit& u, int wr, int wc, int fr, int fq) const {
        const int pnl = u.pn & 15, row0 = u.pm * BM + wr * 64 + fr, col0 = pnl * BM + wc * 32 + 8 * fq;
        int tok[8];
#pragma unroll
        for (int i = 0; i < 8; ++i) tok[i] = tokmap[row0 + (i >> 2) * HALF + (i & 3) * 16];
#pragma unroll
        for (int ai = 0; ai < 2; ++ai)
#pragma unroll
            for (int m = 0; m < 4; ++m) { const int tk = tok[ai * 4 + m];
                if (tk >= 0) { const bf16_t* xr = x1 + (size_t)tk * 4096 + col0; bf16_t* rp = R2 + (size_t)tk * 4096 + col0;
                    const u32x4 xa = *(const u32x4*)xr, xb = *(const u32x4*)(xr + HALF);
#pragma unroll
                    for (int bj = 0; bj < 2; ++bj) { const u32x4 x = bj ? xb : xa;
                        const f32x4 v0 = (f32x4){bflo(x.x), bfhi(x.x), bflo(x.y), bfhi(x.y)} * ALPHA_DN + acc[ai][bj][m][0], v1 = (f32x4){bflo(x.z), bfhi(x.z), bflo(x.w), bfhi(x.w)} * ALPHA_DN + acc[ai][bj][m][1];
                        u32x4 w; w.x = cvt_pk_bf16(v0[0], v0[1]); w.y = cvt_pk_bf16(v0[2], v0[3]); w.z = cvt_pk_bf16(v1[0], v1[1]); w.w = cvt_pk_bf16(v1[2], v1[3]);
                        *(u32x4*)(rp + bj * HALF) = w; } } }
    }
};

typedef __attribute__((address_space(1))) unsigned pg8_gu32;
template <int ROLE> struct MoeOrderT {
    int tb[9]; int G, c; unsigned* rdy;
    __device__ __forceinline__ void init(const unsigned* cnt, int G_, int c_, unsigned* rdy_ = nullptr) { G = G_; rdy = rdy_; tb[0] = 0;
#pragma unroll
        for (int g = 0; g < 8; ++g) tb[g + 1] = tb[g] + (int)((__builtin_amdgcn_readfirstlane(cnt[g]) + 255u) >> 8);
        c = ROLE == 2 ? (c_ - (tb[8] * 16) % G_ + G_) % G_ : c_; }
    __device__ __forceinline__ bool next(int i, Unit& u) const {
        const int L = i * G + c; if (L >= tb[8] * 16) return false;
        const int rt = L >> 4, pnl = L & 15; int g = 0;
#pragma unroll
        for (int k = 1; k < 8; ++k) g += (rt >= tb[k]) ? 1 : 0;
        u.pm = rt; u.pn = g * 16 + pnl; return true;
    }
    __device__ __forceinline__ void a_ready(const Unit& u) const {
        if constexpr (ROLE == 2) { pg8_gu32* w = (pg8_gu32*)(rdy + u.pm * 16); unsigned spins = 0;
            while ((unsigned)__builtin_amdgcn_readfirstlane(__hip_atomic_load(w, __ATOMIC_RELAXED, __HIP_MEMORY_SCOPE_AGENT)) < 128u) { __builtin_amdgcn_s_sleep(1); if (++spins > (1u << 22)) break; }
            __builtin_amdgcn_fence(__ATOMIC_ACQUIRE, "agent"); }
    }
    __device__ __forceinline__ void done(const Unit& u) const {
        if constexpr (ROLE == 1) { asm volatile("s_waitcnt vmcnt(0)" ::: "memory");
            if ((threadIdx.x & 63) == 0) __hip_atomic_fetch_add((pg8_gu32*)(rdy + u.pm * 16), 1u, __ATOMIC_RELAXED, __HIP_MEMORY_SCOPE_AGENT); }
    }
};
typedef MoeOrderT<0> MoeOrder;
typedef int i32x4_f8 __attribute__((ext_vector_type(4))); typedef int i32x8_f8 __attribute__((ext_vector_type(8)));
__device__ __forceinline__ i32x8_f8 cat8(const bf16x8 a, const bf16x8 b) { return __builtin_shufflevector(__builtin_bit_cast(i32x4_f8, a), __builtin_bit_cast(i32x4_f8, b), 0, 1, 2, 3, 4, 5, 6, 7); }
template <int OA, int OB, int BFMT> __device__ __forceinline__ f32x4 mfma8(const i32x8_f8 a, const i32x8_f8 b, const f32x4 c, int sa, int sb) { return __builtin_amdgcn_mfma_scale_f32_16x16x128_f8f6f4(a, b, c, 0, BFMT, OA, sa, OB, sb); }
template <class Epi, class Sched, bool ALIGN_EPI = false, bool SP2 = false, int F8 = 0>
__device__ __forceinline__ void gemm_phase(PG8_LAS unsigned char* lds, const Gemm g, const Sched& S, const Epi& E) {
    const int tid = threadIdx.x, wid = __builtin_amdgcn_readfirstlane(tid >> 6), lane = tid & 63, wr = wid >> 2, wc = wid & 3, fr = lane & 15, fq = lane >> 4;
    const int K = g.K, nt = K / BK;
    unsigned voffA[2], voffB[2];
#pragma unroll
    for (int i = 0; i < 2; ++i) { int R, C; stage_rc(tid * 16 + i * 8192, R, C); const int Rb = Epi::PERM ? ((R & ~31) + perm32(R & 31)) : R;
        voffA[i] = (unsigned)(R * K + C) * 2u; voffB[i] = (unsigned)(Rb * K + C) * 2u; }
    const size_t kstep = (size_t)(BK * 2);
    const size_t hstep = (size_t)HALF * K * 2;
    const size_t tstep = 2 * hstep;
    const unsigned ldsw = (unsigned)wid * 1024u;
    const int aoff = lds_byte(wr * 64 + fr, fq * 8), boff = lds_byte(wc * 32 + fr, fq * 8);
#define PG8_SA(b, h) (((b) * 2 + (h)) * HTB)
#define PG8_SB(b, h) ((4 + (b) * 2 + (h)) * HTB)
#define PG8_STAGE(bufoff, gbase, voff) do { _Pragma("unroll") for (int _i = 0; _i < 2; ++_i) { unsigned _vo = (voff)[_i]; if constexpr (F8 != 0) asm volatile("" : "+v"(_vo)); \
        __builtin_amdgcn_global_load_lds((const unsigned*)((const char*)(gbase) + _vo), (PG8_LAS unsigned*)(lds + (bufoff) + ldsw + _i * 8192), 16, 0, 0); } } while (0)
#define PG8_LDA(dst, b, h) do { _Pragma("unroll") for (int m = 0; m < 4; ++m) _Pragma("unroll") for (int k = 0; k < 2; ++k) dst[m][k] = *(const PG8_LAS bf16x8*)(lds + PG8_SA(b, h) + aoff + m * 2048 + k * 1024); } while (0)
#define PG8_LDB(dst, b, h) do { _Pragma("unroll") for (int n = 0; n < 2; ++n) _Pragma("unroll") for (int k = 0; k < 2; ++k) dst[n][k] = *(const PG8_LAS bf16x8*)(lds + PG8_SB(b, h) + boff + n * 2048 + k * 1024); } while (0)
#define PG8_M8(ai, bj, m, n, At, Bt) acc[ai][bj][m][n] = mfma8<(bj) * 2 + (n), (m), (F8 == 2 ? 1 : 0)>(cat8(Bt[n][0], Bt[n][1]), cat8(At[m][0], At[m][1]), acc[ai][bj][m][n], (int)sBk, (int)sAc[ai])
#define PG8_MMA(ai, bj, At, Bt) do { __builtin_amdgcn_s_setprio(1); if constexpr (F8 != 0) { PG8_M8(ai, bj, 0, 0, At, Bt); PG8_M8(ai, bj, 0, 1, At, Bt); PG8_M8(ai, bj, 1, 0, At, Bt); PG8_M8(ai, bj, 1, 1, At, Bt); \
        PG8_M8(ai, bj, 2, 0, At, Bt); PG8_M8(ai, bj, 2, 1, At, Bt); PG8_M8(ai, bj, 3, 0, At, Bt); PG8_M8(ai, bj, 3, 1, At, Bt); } else { \
        _Pragma("unroll") for (int m = 0; m < 4; ++m) _Pragma("unroll") for (int n = 0; n < 2; ++n) _Pragma("unroll") for (int k = 0; k < 2; ++k) \
        acc[ai][bj][m][n] = __builtin_amdgcn_mfma_f32_16x16x32_bf16(Bt[n][k], At[m][k], acc[ai][bj][m][n], 0, 0, 0); } __builtin_amdgcn_s_setprio(0); } while (0)
#define PG8_WAIT_V(n) asm volatile("s_waitcnt vmcnt(" #n ")" ::: "memory")
#define PG8_WAIT_L(n) asm volatile("s_waitcnt lgkmcnt(" #n ")" ::: "memory")
#define PG8_BAR __builtin_amdgcn_s_barrier()
#define PG8_SCHED __builtin_amdgcn_sched_barrier(0)
    Unit cur, nxt; int ui = 0;
    if (!S.next(0, cur)) return;
    f32x4 acc[2][2][4][2];
#pragma unroll
    for (int a = 0; a < 2; ++a)
#pragma unroll
        for (int b = 0; b < 2; ++b)
#pragma unroll
            for (int m = 0; m < 4; ++m)
#pragma unroll
                for (int n = 0; n < 2; ++n) acc[a][b][m][n] = (f32x4){0.f, 0.f, 0.f, 0.f};
    bf16x8 At[4][2], B0[2][2], B1[2][2];
    const char* cA = (const char*)g.A + (size_t)cur.pm * tstep; const char* cB = (const char*)g.Bt + (size_t)cur.pn * tstep;
    const char* cS = nullptr; const char* nS = nullptr; unsigned sBk = 0, sBx = 0, sBy = 0, sAc[2] = {0, 0};
    const unsigned soff = (unsigned)(wc * 128 + lane * 2) * 4u, saoff = (unsigned)(wr * 32 + fr) * 4u;
    const size_t sstep = (size_t)(nt >> 1) * 2048;
    if constexpr (F8 != 0) { cS = (const char*)g.sB + (size_t)cur.pn * sstep; sBx = *(const unsigned*)(cS + soff); sBy = *(const unsigned*)(cS + soff + 4); }
    if constexpr (F8 == 1) { const char* sa = (const char*)g.sA + (size_t)cur.pm * 256; sAc[0] = *(const unsigned*)(sa + saoff); sAc[1] = *(const unsigned*)(sa + saoff + 64); }
    if constexpr (F8 == 2) { sAc[0] = 0x7f7f7f7fu; sAc[1] = 0x7f7f7f7fu; }
    const char* cSA = nullptr; const char* nSA = nullptr; unsigned sAn[2] = {0, 0}; const size_t sastep = (size_t)(nt >> 1) * 256;
    if constexpr (F8 == 3) { cSA = (const char*)g.sA + (size_t)cur.pm * sastep; sAc[0] = *(const unsigned*)(cSA + saoff); sAc[1] = *(const unsigned*)(cSA + saoff + 64); }
    S.a_ready(cur);
    if constexpr (SP2) {
        PG8_STAGE(PG8_SB(0, 0), cB, voffB); PG8_STAGE(PG8_SB(0, 1), cB + hstep, voffB); PG8_STAGE(PG8_SA(0, 0), cA, voffA); PG8_STAGE(PG8_SA(0, 1), cA + hstep, voffA);
        if (wr == 1) PG8_BAR;
        PG8_WAIT_V(2); PG8_BAR;
        PG8_STAGE(PG8_SB(1, 0), cB + kstep, voffB); PG8_STAGE(PG8_SA(1, 0), cA + kstep, voffA); PG8_STAGE(PG8_SB(1, 1), cB + hstep + kstep, voffB);
        PG8_WAIT_V(6); PG8_BAR;
    } else {
        PG8_STAGE(PG8_SB(0, 0), cB, voffB); PG8_STAGE(PG8_SA(0, 0), cA, voffA); PG8_STAGE(PG8_SB(0, 1), cB + hstep, voffB); PG8_STAGE(PG8_SA(0, 1), cA + hstep, voffA);
        if (wr == 1) PG8_BAR;
        PG8_WAIT_V(4); PG8_BAR;
        PG8_STAGE(PG8_SB(1, 0), cB + kstep, voffB); PG8_STAGE(PG8_SA(1, 0), cA + kstep, voffA); PG8_STAGE(PG8_SB(1, 1), cB + hstep + kstep, voffB);
        PG8_WAIT_V(6); PG8_BAR;
    }
    for (;;) {
        const bool has_next = S.next(ui + 1, nxt);
        const char* nA = has_next ? (const char*)g.A + (size_t)nxt.pm * tstep : cA; const char* nB = has_next ? (const char*)g.Bt + (size_t)nxt.pn * tstep : cB;
        if constexpr (F8 != 0) nS = has_next ? (const char*)g.sB + (size_t)nxt.pn * sstep : cS;
        if constexpr (F8 == 3) nSA = has_next ? (const char*)g.sA + (size_t)nxt.pm * sastep : cSA;
        for (int t = 0; t < nt; t += 2) {
            const bool last = (t == nt - 2);
            const char* a1 = cA + (size_t)(t + 1) * kstep;
            const char* a2 = last ? nA : cA + (size_t)(t + 2) * kstep; const char* b2 = last ? nB : cB + (size_t)(t + 2) * kstep;
            const char* a3 = a2 + kstep; const char* b3 = b2 + kstep;
            if (last && has_next) S.a_ready(nxt);
            if constexpr (F8 == 3) { const char* a2 = last ? nSA : cSA + ((t >> 1) + 1) * 256; sAn[0] = *(const unsigned*)(a2 + saoff); sAn[1] = *(const unsigned*)(a2 + saoff + 64); }
            const char* s2 = nullptr; if constexpr (F8 != 0) { s2 = last ? nS : cS + ((t >> 1) + 1) * 2048; sBk = sBx; }
            if constexpr (Epi::MIDK) { if (t == E.tsplit) { PG8_WAIT_V(0); PG8_SCHED; E.mid(acc, cur, wr, wc, fr, fq); PG8_WAIT_V(0); PG8_SCHED; } }
            if constexpr (SP2) {
            PG8_LDB(B0, 0, 0); PG8_LDB(B1, 0, 1); PG8_SCHED; PG8_LDA(At, 0, 0); PG8_STAGE(PG8_SA(1, 1), a1 + hstep, voffA);
            PG8_WAIT_V(8); PG8_WAIT_L(0); PG8_BAR; PG8_MMA(0, 0, At, B0); PG8_MMA(0, 1, At, B1); PG8_BAR; PG8_SCHED;
            PG8_LDA(At, 0, 1); PG8_STAGE(PG8_SB(0, 0), b2, voffB); PG8_STAGE(PG8_SB(0, 1), b2 + hstep, voffB); PG8_STAGE(PG8_SA(0, 0), a2, voffA);
            PG8_WAIT_V(8); PG8_WAIT_L(0); PG8_BAR; PG8_MMA(1, 0, At, B0); PG8_MMA(1, 1, At, B1); PG8_BAR; PG8_SCHED;
            if constexpr (F8 != 0) { sBx = *(const unsigned*)(s2 + soff); sBk = sBy; }
            PG8_LDB(B0, 1, 0); PG8_LDB(B1, 1, 1); PG8_SCHED; PG8_LDA(At, 1, 0); PG8_STAGE(PG8_SA(0, 1), a2 + hstep, voffA);
            PG8_WAIT_V(8); PG8_WAIT_L(0); PG8_BAR; PG8_MMA(0, 0, At, B0); PG8_MMA(0, 1, At, B1); PG8_BAR; PG8_SCHED;
            PG8_LDA(At, 1, 1); PG8_STAGE(PG8_SB(1, 0), b3, voffB); PG8_STAGE(PG8_SB(1, 1), b3 + hstep, voffB); PG8_STAGE(PG8_SA(1, 0), a3, voffA);
            PG8_WAIT_V(8); PG8_WAIT_L(0); PG8_BAR; PG8_MMA(1, 0, At, B0); PG8_MMA(1, 1, At, B1); PG8_BAR; PG8_SCHED;
            if constexpr (F8 != 0) sBy = *(const unsigned*)(s2 + soff + 4);
            if constexpr (F8 == 3) { sAc[0] = sAn[0]; sAc[1] = sAn[1]; }
            } else {
            PG8_LDB(B0, 0, 0); PG8_SCHED; PG8_LDA(At, 0, 0); PG8_STAGE(PG8_SA(1, 1), a1 + hstep, voffA);
            PG8_WAIT_L(8); PG8_BAR; PG8_WAIT_L(0); PG8_MMA(0, 0, At, B0); PG8_BAR; PG8_SCHED;
            PG8_LDB(B1, 0, 1); PG8_STAGE(PG8_SB(0, 0), b2, voffB);
            PG8_BAR; PG8_WAIT_L(0); PG8_MMA(0, 1, At, B1); PG8_BAR;
            PG8_LDA(At, 0, 1); PG8_STAGE(PG8_SA(0, 0), a2, voffA);
            PG8_BAR; PG8_WAIT_L(0); PG8_MMA(1, 0, At, B0); PG8_BAR; PG8_SCHED;
            PG8_STAGE(PG8_SB(0, 1), b2 + hstep, voffB);
            PG8_WAIT_V(6); PG8_BAR; PG8_MMA(1, 1, At, B1); PG8_BAR;
            PG8_LDB(B0, 1, 0); PG8_SCHED; PG8_LDA(At, 1, 0); PG8_STAGE(PG8_SA(0, 1), a2 + hstep, voffA);
            PG8_WAIT_L(8); PG8_BAR; PG8_WAIT_L(0); PG8_MMA(0, 0, At, B0); PG8_BAR; PG8_SCHED;
            PG8_LDB(B1, 1, 1); PG8_STAGE(PG8_SB(1, 0), b3, voffB);
            PG8_BAR; PG8_WAIT_L(0); PG8_MMA(0, 1, At, B1); PG8_BAR;
            PG8_LDA(At, 1, 1); PG8_STAGE(PG8_SA(1, 0), a3, voffA);
            PG8_BAR; PG8_WAIT_L(0); PG8_MMA(1, 0, At, B0); PG8_BAR; PG8_SCHED;
            PG8_STAGE(PG8_SB(1, 1), b3 + hstep, voffB);
            PG8_WAIT_V(6); PG8_BAR; PG8_MMA(1, 1, At, B1); PG8_BAR;
            }
        }
        if constexpr (ALIGN_EPI) { if (wr == 0) PG8_BAR; }
        if constexpr (!Epi::AFTER_DRAIN) { int fr2 = fr, fq2 = fq; asm volatile("" : "+v"(fr2), "+v"(fq2));
            E(acc, cur, wr, wc, fr2, fq2); S.done(cur); }
        if (!has_next) break;
#pragma unroll
        for (int a = 0; a < 2; ++a)
#pragma unroll
            for (int b = 0; b < 2; ++b)
#pragma unroll
                for (int m = 0; m < 4; ++m)
#pragma unroll
                    for (int n = 0; n < 2; ++n) acc[a][b][m][n] = (f32x4){0.f, 0.f, 0.f, 0.f};
        cur = nxt; cA = nA; cB = nB; ++ui;
        if constexpr (F8 != 0) cS = nS;
        if constexpr (F8 == 3) cSA = nSA;
        if constexpr (F8 == 1) { const char* sa = (const char*)g.sA + (size_t)cur.pm * 256; sAc[0] = *(const unsigned*)(sa + saoff); sAc[1] = *(const unsigned*)(sa + saoff + 64); }
        if constexpr (ALIGN_EPI) { if (wr == 1) PG8_BAR; }
    }
    PG8_WAIT_V(0);
    if constexpr (!ALIGN_EPI) { if (wr == 0) PG8_BAR; }
    PG8_BAR;
    if constexpr (Epi::AFTER_DRAIN) { E.fused(acc, cur, wr, wc, fr, fq, lds, wid, lane); S.done(cur); }
#undef PG8_SA
#undef PG8_SB
#undef PG8_STAGE
#undef PG8_LDA
#undef PG8_LDB
#undef PG8_MMA
#undef PG8_M8
#undef PG8_WAIT_V
#undef PG8_WAIT_L
#undef PG8_BAR
#undef PG8_SCHED
}
}
constexpr int NWAVES = 8, NTHR = 512;
constexpr int T = 8704, TP = 8192, DM = 4096, LDH = pg8::LDH;
constexpr int C_Z = pg8::C_Z, C_XBC = pg8::C_XBC, C_U = pg8::C_U, C_V = pg8::C_V, C_G1 = pg8::C_G1, C_G2 = pg8::C_G2;
constexpr int XG_ROWS = 10752;
constexpr float LN_EPS = 1e-5f, RMS_EPS = 1e-5f;
constexpr size_t MiB = 1u << 20;
constexpr size_t WS_CTL = 0, CTL_ZERO_BYTES = 64 * 1024;
constexpr size_t WS_WIN = 1 * MiB;
constexpr size_t WS_WP = WS_WIN + 178 * MiB;
constexpr size_t WS_WOUT = WS_WP + 48 * MiB;
constexpr size_t WS_WGU = WS_WOUT + 32 * MiB;
constexpr size_t WS_WDN = WS_WGU + 256 * MiB;
constexpr size_t WS_XB = WS_WDN + 128 * MiB;
constexpr size_t WS_H = WS_XB + 68 * MiB;
constexpr size_t WS_XG = WS_H, WS_HM = WS_H + 96 * MiB;
constexpr size_t WS_SBGU = WS_WGU + 128 * MiB, WS_SBDN = WS_WGU + 132 * MiB, WS_SAXG = WS_WGU + 134 * MiB;
constexpr size_t WS_DT = WS_H + 379 * MiB;
constexpr size_t WS_YRAW = WS_DT + 3 * MiB;
constexpr size_t WS_X8 = WS_YRAW, WS_W8 = WS_YRAW + 34 * MiB, WS_SB8 = WS_YRAW + 123 * MiB, WS_SA8 = WS_YRAW + 126 * MiB;
constexpr size_t WS_YCAT = WS_YRAW + 136 * MiB;
constexpr size_t WS_MRG = WS_YCAT + 102 * MiB;
constexpr size_t WS_R1 = WS_MRG + 68 * MiB;
constexpr size_t WS_SMALL = WS_R1 + 136 * MiB;
constexpr size_t WS_WRF = WS_SMALL + 1 * MiB;
constexpr size_t WS_G8 = WS_WRF + 1 * MiB;
constexpr size_t WS_END = WS_G8 + 68 * MiB;
constexpr size_t SM_GRP = 0, SM_RANK = 65536, SM_GW = 131072, SM_TOK = 327680, SM_GWS = 393216;
constexpr int CW_CNT = 64;
constexpr int CW_BAR = 4096;
constexpr int CW_RDY = 1024;
constexpr int RING_BYTES = 131072, MISC_OFF = 139264 + 320  , LDS_BYTES = 147456;

#define GAS __attribute__((address_space(1)))
#define LAS __attribute__((address_space(3)))
typedef unsigned short bf16;
typedef unsigned v4u __attribute__((ext_vector_type(4)));
typedef unsigned v2u __attribute__((ext_vector_type(2)));
typedef float f32x4 __attribute__((ext_vector_type(4)));
typedef GAS unsigned gu32;
#define RLX_AGENT __ATOMIC_RELAXED, __HIP_MEMORY_SCOPE_AGENT
#define LDS_WAIT() asm volatile("s_waitcnt lgkmcnt(0)" ::: "memory")
#define VM_WAIT() asm volatile("s_waitcnt vmcnt(0)" ::: "memory")
typedef float f32x2_pk __attribute__((ext_vector_type(2))); typedef __bf16 bf16x2_pk __attribute__((ext_vector_type(2)));
__device__ __forceinline__ unsigned pk2(float lo, float hi) { const f32x2_pk v = {lo, hi}; const bf16x2_pk b = __builtin_convertvector(v, bf16x2_pk); return __builtin_bit_cast(unsigned, b); }
__device__ __forceinline__ unsigned f2bf(float f) { return pk2(f, 0.f) & 0xffffu; }
__device__ __forceinline__ float bflo(unsigned w) { return __builtin_bit_cast(float, w << 16); }
__device__ __forceinline__ float bfhi(unsigned w) { return __builtin_bit_cast(float, w & 0xffff0000u); }
__device__ __forceinline__ float wave_sum(float v) {
#pragma unroll
    for (int o = 1; o < 64; o <<= 1) v += __shfl_xor(v, o);
    return v;
}
__device__ __forceinline__ float sigmf(float a) { return 1.0f / (1.0f + __expf(-a)); }
#define XB_TMO      128
#define XB_XCNT(j)  (256  + 64 * (j))
#define XB_XSUB(j)  (1280 + 64 * (j))
#define XB_XGEN(j)  (2304 + 64 * (j))
#define XB_TOP      3328
#define XB_TOPGEN   3392
#define XCD_BAR_WORDS 3456
#define XB_SPIN_CAP (1u << 18)

__device__ __forceinline__ unsigned xb_ld(unsigned* p)              { return __hip_atomic_load(p, __ATOMIC_RELAXED, __HIP_MEMORY_SCOPE_AGENT); }
__device__ __forceinline__ unsigned xb_add(unsigned* p, unsigned v) { return __hip_atomic_fetch_add(p, v, __ATOMIC_RELAXED, __HIP_MEMORY_SCOPE_AGENT); }
__device__ __forceinline__ unsigned xb_xcc_id() { return (unsigned)__builtin_amdgcn_s_getreg((3 << 11) | 20) & 0xFu; }
#define XB_SPIN(cond, bar) do { unsigned _sp = 0; while (cond) { __builtin_amdgcn_s_sleep(1); \
    if ((++_sp & 255u) == 0u) { if (xb_ld(&(bar)[XB_TMO])) break; if (_sp > XB_SPIN_CAP) { atomicAdd(&(bar)[XB_TMO], 1u); break; } } } } while (0)

struct XcdBarrier {
    unsigned* bar; unsigned x;
    volatile LAS unsigned* st;
};

__device__ __forceinline__ XcdBarrier xcd_barrier_post(unsigned* bar, volatile LAS unsigned* st) {
    XcdBarrier b; b.bar = bar; b.x = xb_xcc_id(); b.st = st;
    if (threadIdx.x == 0) (void)xb_add(&bar[XB_XCNT(b.x)], 1u);
    return b;
}
__device__ __forceinline__ void xcd_barrier_complete(unsigned* bar, unsigned x, unsigned& nloc, unsigned& nx) {
    const unsigned G = gridDim.x * gridDim.y * gridDim.z;
    unsigned sum, cnt, mine, sp = 0u;
    for (;;) {
        sum = 0u; cnt = 0u; mine = 0u;
#pragma unroll
        for (unsigned j = 0; j < 16; ++j) { const unsigned c = xb_ld(&bar[XB_XCNT(j)]); sum += c; cnt += (c > 0u) ? 1u : 0u; mine = (j == x) ? c : mine; }
        if (sum == G) break;
        __builtin_amdgcn_s_sleep(1);
        if ((++sp & 255u) == 0u) { if (xb_ld(&bar[XB_TMO])) break; if (sp > XB_SPIN_CAP) { atomicAdd(&bar[XB_TMO], 1u); break; } }
    }
    nloc = mine > 0u ? mine : 1u; nx = cnt > 0u ? cnt : 1u;
}

__device__ __forceinline__ void xcd_barrier(const XcdBarrier& b) {
    asm volatile("s_waitcnt vmcnt(0)" ::: "memory");
    __syncthreads();
    if (threadIdx.x == 0) {
        unsigned* bar = b.bar;
        __builtin_amdgcn_s_waitcnt(0);
        unsigned nloc = b.st[0], nx = b.st[1];
        if (nloc == 0u) { xcd_barrier_complete(bar, b.x, nloc, nx); b.st[0] = nloc; b.st[1] = nx; }
        const unsigned old = xb_add(&bar[XB_XSUB(b.x)], 1u);
        const unsigned gen = old / nloc;
        if (old + 1u == (gen + 1u) * nloc) {
            __builtin_amdgcn_fence(__ATOMIC_RELEASE, "agent");
            asm volatile("s_waitcnt vmcnt(0)" ::: "memory");
            const unsigned og = xb_add(&bar[XB_TOP], 1u);
            const unsigned tg = og / nx;
            if (og + 1u == (tg + 1u) * nx) xb_add(&bar[XB_TOPGEN], 1u);
            else XB_SPIN(xb_ld(&bar[XB_TOPGEN]) == tg, bar);
            __builtin_amdgcn_fence(__ATOMIC_ACQUIRE, "agent");
            xb_add(&bar[XB_XGEN(b.x)], 1u);
            asm volatile("s_waitcnt vmcnt(0)" ::: "memory");
        } else {
            XB_SPIN(xb_ld(&bar[XB_XGEN(b.x)]) == gen, bar);
            __builtin_amdgcn_fence(__ATOMIC_ACQUIRE, "agent");
            asm volatile("s_waitcnt vmcnt(0)" ::: "memory");
        }
    }
    __syncthreads();
}
#ifndef REP_SSDP
#define REP_SSDP 1
#endif
#ifndef REP_SSDS
#define REP_SSDS 1
#endif
#ifndef REP_P2
#define REP_P2 1
#endif
#ifndef REP_P11
#define REP_P11 1
#endif
#ifndef REP_P5
#define REP_P5 1
#endif
#ifndef REP_P6
#define REP_P6 1
#endif
#ifndef REP_P9
#define REP_P9 1
#endif
#ifndef REP_P10
#define REP_P10 1
#endif
#ifndef REP_P0
#define REP_P0 1
#endif
#ifndef REP_P1
#define REP_P1 1
#endif
#ifndef REP_SSD
#define REP_SSD 1
#endif
#ifndef REP_RT
#define REP_RT 1
#endif
#ifndef REP_P4
#define REP_P4 1
#endif
__device__ __forceinline__ void tr_item(const float* W, size_t ldw, int k0, int n0, bf16* dst, size_t ldd, int drow0, int dcol0, LAS float* scr, int lane) {
#pragma unroll 8
    for (int i = 0; i < 32; ++i) { const int kk = 2 * i + (lane >> 5); scr[kk * 33 + (lane & 31)] = W[(size_t)(k0 + kk) * ldw + n0 + (lane & 31)]; }
    LDS_WAIT(); asm volatile("" ::: "memory");
    const int c = lane & 7;
#pragma unroll
    for (int j = 0; j < 4; ++j) { const int n = (lane >> 3) + 8 * j; const LAS float* s = scr + (8 * c) * 33 + n;
        v4u o; o.x = pk2(s[0 * 33], s[1 * 33]); o.y = pk2(s[2 * 33], s[3 * 33]); o.z = pk2(s[4 * 33], s[5 * 33]); o.w = pk2(s[6 * 33], s[7 * 33]);
        *(v4u*)(dst + (size_t)(drow0 + n) * ldd + dcol0 + k0 + 8 * c) = o; }
    LDS_WAIT(); asm volatile("" ::: "memory");
}
using pg8::e8m0_of; using pg8::e8m0_inv; using pg8::pk4_fp8;
__device__ __forceinline__ void tr_item8(const float* W, size_t ldw, int k0, int n0, unsigned char* dst, unsigned char* sb8, int drow0, LAS float* scr, int lane, int rowb = 4096, int dcol0 = 0, int pairs = 16) {
#pragma unroll 8
    for (int i = 0; i < 64; ++i) { const int kk = 2 * i + (lane >> 5); scr[kk * 33 + (lane & 31)] = W[(size_t)(k0 + kk) * ldw + n0 + (lane & 31)]; }
    LDS_WAIT(); asm volatile("" ::: "memory");
    const int c = lane & 7, kt = (dcol0 + k0) >> 7;
#pragma unroll
    for (int j = 0; j < 4; ++j) { const int n = (lane >> 3) + 8 * j; const LAS float* sp = scr + (16 * c) * 33 + n;
        float v[16]; float am = 0.f;
#pragma unroll
        for (int i = 0; i < 16; ++i) { v[i] = sp[i * 33]; am = fmaxf(am, fabsf(v[i])); }
        am = fmaxf(am, __shfl_xor(am, 1)); am = fmaxf(am, __shfl_xor(am, 2)); am = fmaxf(am, __shfl_xor(am, 4));
        const int sb = e8m0_of(am); const float inv = e8m0_inv(sb);
        v4u o; o.x = pk4_fp8(v[0] * inv, v[1] * inv, v[2] * inv, v[3] * inv); o.y = pk4_fp8(v[4] * inv, v[5] * inv, v[6] * inv, v[7] * inv);
        o.z = pk4_fp8(v[8] * inv, v[9] * inv, v[10] * inv, v[11] * inv); o.w = pk4_fp8(v[12] * inv, v[13] * inv, v[14] * inv, v[15] * inv);
        const int nrow = drow0 + n;
        *(v4u*)(dst + (size_t)nrow * rowb + dcol0 + k0 + 16 * c) = o;
        if (c < 4) { const int pn = nrow >> 8, rr = nrow & 255, bj = rr >> 7, wcc = (rr >> 5) & 3, pp = rr & 31, fr = 4 * (pp >> 3) + (pp & 3), nn = (pp >> 2) & 1;
            sb8[((((size_t)(pn * pairs + (kt >> 1)) * 4 + wcc) * 64 + c * 16 + fr) * 2 + (kt & 1)) * 4 + bj * 2 + nn] = (unsigned char)sb; }
    }
    LDS_WAIT(); asm volatile("" ::: "memory");
}
struct P0Args { const float *w_in, *p_ssd, *p_sg, *w_out, *w_gate, *w_up, *w_down, *xp, *xs; bf16 *Wt_in, *Wt_p, *Wt_out, *Wt_gu, *Wt_dn, *xb; const float *w_rg, *w_re; v4u* wrf; unsigned char *x8, *W8, *sb8, *sa8, *Wgu8, *Wdn8, *sbgu, *sbdn, *Wo8, *sbwo, *Wp8, *sbwp; };
__device__ __forceinline__ void moe_item8(const P0Args& a, int r, LAS float* scr, int lane) {
    constexpr int I_EX = 32 * 512;
    if (r < 2 * I_EX) { const int up = r >= I_EX ? 1 : 0; if (up) r -= I_EX;
        const int e = r >> 9, q = r & 511, kb = q >> 4, n0 = (q & 15) * 32;
        const int g = e >> 2, el = e & 3, drow = g * 4096 + el * 1024 + (n0 >> 7) * 256 + up * 128 + (n0 & 127);
        tr_item8((up ? a.w_up : a.w_gate) + (size_t)e * 4096 * 512, 512, kb * 128, n0, a.Wgu8, a.sbgu, drow, scr, lane, 4096, 0, 16); return; } r -= 2 * I_EX;
    { const int e = r >> 9, q = r & 511, kb = q >> 7, n0 = (q & 127) * 32;
        const int g = e >> 2, el = e & 3;
        tr_item8(a.w_down + (size_t)e * 512 * 4096, 4096, kb * 128, n0, a.Wdn8, a.sbdn, g * 4096 + n0, scr, lane, 2048, el * 512, 8); }
}
__device__ __forceinline__ void p0_convert(const P0Args& a, LAS unsigned char* lds, int gw, int NGW, int wave, int lane, bool with_moe) {
    LAS float* scr = (LAS float*)(lds + wave * 17408);
    constexpr int I_IN = 64 * 706, I_PS = 32 * 128, I_PG = 16 * 128, I_WO = 64 * 128, I_EX = 32 * 512;
    const int NITEMS = I_IN + I_PS + I_PG + (with_moe ? I_WO + 3 * I_EX : 0);
    for (int it = gw; it < NITEMS; it += NGW) {
        int r = it;
        if (r < I_IN) { const int kb = r / 706, n0 = (r % 706) * 32; const int drow = n0 < 10240 ? n0 : (n0 < 10304 ? n0 - 10240 + 22528 : n0 - 64);
            const bool f8 = drow < 4096 || (drow >= 10240 && drow < 12288) || (drow >= 14336 && drow < 22528);
            const bool vcol = drow >= 12288 && drow < 14336;
            if (!f8) tr_item(a.w_in, 22592, kb * 64, n0, a.Wt_in, 4096, drow, 0, scr, lane);
            if ((f8 || vcol) && !(kb & 1)) tr_item8(a.w_in, 22592, kb * 64, n0, a.W8, a.sb8, drow, scr, lane);
            continue; } r -= I_IN;
        if (r < I_PS) { const int kb = r / 128, n0 = (r % 128) * 32; tr_item8(a.p_ssd, 4096, kb * 128, n0, a.Wp8, a.sbwp, n0, scr, lane, 6144, 0, 24); continue; } r -= I_PS;
        if (r < I_PG) { const int kb = r / 128, n0 = (r % 128) * 32; tr_item8(a.p_sg, 4096, kb * 128, n0, a.Wp8, a.sbwp, n0, scr, lane, 6144, 4096, 24); continue; } r -= I_PG;
        if (r < I_WO) { const int kb = r / 128, n0 = (r % 128) * 32; if (!(kb & 1)) tr_item8(a.w_out, 4096, kb * 64, n0, a.Wo8, a.sbwo, n0, scr, lane, 4096, 0, 16); continue; } r -= I_WO;
        moe_item8(a, r, scr, lane);
    }
    for (int it = gw * 64 + lane; it < 128 * 3 * 64; it += NGW * 64) { const int l = it & 63, c = (it >> 6) % 3, sk = it / 192, o = 16 * c + (l & 15), k0 = 32 * sk + 8 * (l >> 4);
        float v[8];
#pragma unroll
        for (int jj = 0; jj < 8; ++jj) v[jj] = o < 32 ? a.w_re[(size_t)(k0 + jj) * 32 + o] : (o < 40 ? a.w_rg[(size_t)(k0 + jj) * 8 + (o - 32)] : 0.f);
        v4u hi, lo; unsigned hw[4], lw[4];
#pragma unroll
        for (int j2 = 0; j2 < 4; ++j2) { hw[j2] = pk2(v[2 * j2], v[2 * j2 + 1]); lw[j2] = pk2(v[2 * j2] - bflo(hw[j2]), v[2 * j2 + 1] - bfhi(hw[j2])); }
        hi.x = hw[0]; hi.y = hw[1]; hi.z = hw[2]; hi.w = hw[3]; lo.x = lw[0]; lo.y = lw[1]; lo.z = lw[2]; lo.w = lw[3];
        a.wrf[((size_t)(sk * 3 + c) * 2 + 0) * 64 + l] = hi; a.wrf[((size_t)(sk * 3 + c) * 2 + 1) * 64 + l] = lo; }
    for (int row = gw; row < T; row += NGW) {
        const float* s = row < TP ? a.xp + (size_t)row * 4096 : a.xs + (size_t)(row - TP) * 4096;
        f32x4 v[16]; float am = 0.f;
#pragma unroll
        for (int i = 0; i < 8; ++i) { v[2 * i] = *(const f32x4*)(s + 8 * (i * 64 + lane)); v[2 * i + 1] = *(const f32x4*)(s + 8 * (i * 64 + lane) + 4); }
#pragma unroll
        for (int i = 0; i < 16; ++i) am = fmaxf(fmaxf(am, fmaxf(fabsf(v[i][0]), fabsf(v[i][1]))), fmaxf(fabsf(v[i][2]), fabsf(v[i][3])));
#pragma unroll
        for (int d = 1; d < 64; d <<= 1) am = fmaxf(am, __shfl_xor(am, d));
        const int sb = e8m0_of(am); const float inv = e8m0_inv(sb);
#pragma unroll
        for (int i = 0; i < 8; ++i) { const f32x4 v0 = v[2 * i], v1 = v[2 * i + 1];
            v4u o; o.x = pk2(v0[0], v0[1]); o.y = pk2(v0[2], v0[3]); o.z = pk2(v1[0], v1[1]); o.w = pk2(v1[2], v1[3]);
            *(v4u*)(a.xb + (size_t)row * 4096 + 8 * (i * 64 + lane)) = o;
            v2u q; q.x = pk4_fp8(v0[0] * inv, v0[1] * inv, v0[2] * inv, v0[3] * inv); q.y = pk4_fp8(v1[0] * inv, v1[1] * inv, v1[2] * inv, v1[3] * inv);
            *(v2u*)(a.x8 + (size_t)row * 4096 + 8 * (i * 64 + lane)) = q; }
        if (lane == 0) a.sa8[(((((row >> 8) * 2 + ((row >> 6) & 1)) * 2 + ((row >> 7) & 1)) * 16 + (row & 15)) * 4) + ((row >> 4) & 3)] = (unsigned char)sb;
    }
}

__device__ __forceinline__ void conv_wout(const P0Args& a, LAS unsigned char* lds, int wi, int NW, int wave, int lane) {
    LAS float* scr = (LAS float*)(lds + wave * 17408);
    for (int r = wi; r < 32 * 128; r += NW) { const int kb = r / 128, n0 = (r % 128) * 32; tr_item8(a.w_out, 4096, kb * 128, n0, a.Wo8, a.sbwo, n0, scr, lane, 4096, 0, 16); }
}
__device__ __forceinline__ void conv_moe(const P0Args& a, LAS unsigned char* lds, int lo, int hi, int wi, int NW, int wave, int lane) {
    LAS float* scr = (LAS float*)(lds + wave * 17408);
    for (int it = lo + wi; it < hi; it += NW) moe_item8(a, it, scr, lane);
}

__device__ __forceinline__ void unpack8(const v4u w, float (&v)[8]) { v[0] = bflo(w.x); v[1] = bfhi(w.x); v[2] = bflo(w.y); v[3] = bfhi(w.y); v[4] = bflo(w.z); v[5] = bfhi(w.z); v[6] = bflo(w.w); v[7] = bfhi(w.w); }
__device__ __forceinline__ void p2_conv(const bf16* H, const float* conv_state, const float* conv_w, const float* conv_b, bf16* xbcc, float* out_conv_p, float* out_conv_s, size_t gtid, size_t gthreads) {
    constexpr int NPI = 512 * 768, NSI = 128 * 768;
    for (size_t idx = gtid; idx < (size_t)(NPI + NSI); idx += gthreads) {
        const bool smp = idx >= (size_t)NPI; const int id = smp ? (int)(idx - NPI) : (int)idx;
        const int c = (id % 768) * 8, run = id / 768;
        const int row0 = smp ? TP + run * 4 : run * 16, nr = smp ? 4 : 16, t0 = smp ? 0 : (row0 & 2047);
        float wk[4][8], bias[8];
#pragma unroll
        for (int k = 0; k < 4; ++k) { const f32x4 w0 = *(const f32x4*)(conv_w + k * 6144 + c), w1 = *(const f32x4*)(conv_w + k * 6144 + c + 4);
#pragma unroll
            for (int j = 0; j < 4; ++j) { wk[k][j] = w0[j]; wk[k][4 + j] = w1[j]; } }
        { const f32x4 b0 = *(const f32x4*)(conv_b + c), b1 = *(const f32x4*)(conv_b + c + 4);
#pragma unroll
          for (int j = 0; j < 4; ++j) { bias[j] = b0[j]; bias[4 + j] = b1[j]; } }
        v4u rw[16];
#pragma unroll
        for (int r = 0; r < 16; ++r) if (r < nr) rw[r] = *(const v4u*)(H + (size_t)(row0 + r) * LDH + C_XBC + c);
        float h0[8], h1[8], h2[8];
        if (smp) { const float* sp = conv_state + (size_t)run * 3 * 6144 + c;
            const f32x4 a0 = *(const f32x4*)(sp), a1 = *(const f32x4*)(sp + 4), b0 = *(const f32x4*)(sp + 6144), b1 = *(const f32x4*)(sp + 6144 + 4), c0 = *(const f32x4*)(sp + 12288), c1 = *(const f32x4*)(sp + 12288 + 4);
#pragma unroll
            for (int j = 0; j < 4; ++j) { h0[j] = a0[j]; h0[4 + j] = a1[j]; h1[j] = b0[j]; h1[4 + j] = b1[j]; h2[j] = c0[j]; h2[4 + j] = c1[j]; } }
        else if (t0 > 0) { unpack8(*(const v4u*)(H + (size_t)(row0 - 3) * LDH + C_XBC + c), h0); unpack8(*(const v4u*)(H + (size_t)(row0 - 2) * LDH + C_XBC + c), h1); unpack8(*(const v4u*)(H + (size_t)(row0 - 1) * LDH + C_XBC + c), h2); }
        else {
#pragma unroll
            for (int j = 0; j < 8; ++j) { h0[j] = 0.f; h1[j] = 0.f; h2[j] = 0.f; } }
#pragma unroll
        for (int r = 0; r < 16; ++r) if (r < nr) {
            float cur[8]; unpack8(rw[r], cur);
            float acc[8];
#pragma unroll
            for (int j = 0; j < 8; ++j) { acc[j] = bias[j] + wk[0][j] * h0[j] + wk[1][j] * h1[j] + wk[2][j] * h2[j] + wk[3][j] * cur[j]; acc[j] = acc[j] * sigmf(acc[j]); }
            v4u o; o.x = pk2(acc[0], acc[1]); o.y = pk2(acc[2], acc[3]); o.z = pk2(acc[4], acc[5]); o.w = pk2(acc[6], acc[7]);
            *(v4u*)(xbcc + (size_t)(row0 + r) * 6144 + c) = o;
            const int t = t0 + r; float* od = nullptr;
            if (!smp && t >= 2045) od = out_conv_p + ((size_t)(row0 >> 11) * 3 + (t - 2045)) * 6144 + c;
            if (smp && t >= 1) od = out_conv_s + ((size_t)run * 3 + (t - 1)) * 6144 + c;
            if (od) { *(f32x4*)od = (f32x4){cur[0], cur[1], cur[2], cur[3]}; *(f32x4*)(od + 4) = (f32x4){cur[4], cur[5], cur[6], cur[7]}; }
#pragma unroll
            for (int j = 0; j < 8; ++j) { h0[j] = h1[j]; h1[j] = h2[j]; h2[j] = cur[j]; }
        }
    }
}

__device__ __forceinline__ void vln_row(bf16* H, const float* g, const float* b, float* out_v, int row, int lane) {
    bf16* rp = H + (size_t)row * LDH + C_V;
    float v[32];
#pragma unroll
    for (int j = 0; j < 4; ++j) { const v4u w = *(const v4u*)(rp + (lane + 64 * j) * 8);
        v[8 * j] = bflo(w.x); v[8 * j + 1] = bfhi(w.x); v[8 * j + 2] = bflo(w.y); v[8 * j + 3] = bfhi(w.y); v[8 * j + 4] = bflo(w.z); v[8 * j + 5] = bfhi(w.z); v[8 * j + 6] = bflo(w.w); v[8 * j + 7] = bfhi(w.w); }
    float s = 0.f;
#pragma unroll
    for (int i = 0; i < 32; ++i) s += v[i];
    const float mean = wave_sum(s) * (1.f / 2048.f); float s2 = 0.f;
#pragma unroll
    for (int i = 0; i < 32; ++i) { v[i] -= mean; s2 += v[i] * v[i]; }
    const float rstd = 1.f / sqrtf(wave_sum(s2) * (1.f / 2048.f) + LN_EPS);
#pragma unroll
    for (int j = 0; j < 4; ++j) { const int c = (lane + 64 * j) * 8;
        const f32x4 g0 = *(const f32x4*)(g + c), g1 = *(const f32x4*)(g + c + 4), b0 = *(const f32x4*)(b + c), b1 = *(const f32x4*)(b + c + 4);
        float o[8];
#pragma unroll
        for (int i = 0; i < 4; ++i) { o[i] = v[8 * j + i] * rstd * g0[i] + b0[i]; o[4 + i] = v[8 * j + 4 + i] * rstd * g1[i] + b1[i]; }
        v4u w; w.x = pk2(o[0], o[1]); w.y = pk2(o[2], o[3]); w.z = pk2(o[4], o[5]); w.w = pk2(o[6], o[7]);
        *(v4u*)(rp + c) = w;
        if (row >= TP) { float* od = out_v + (size_t)(row - TP) * 2048 + c; *(f32x4*)od = (f32x4){o[0], o[1], o[2], o[3]}; *(f32x4*)(od + 4) = (f32x4){o[4], o[5], o[6], o[7]}; } }
}

__device__ __forceinline__ size_t sa_idx(int row, int pair, int npairs) { return ((((size_t)((row >> 8) * npairs + pair) * 2 + ((row >> 6) & 1)) * 2 + ((row >> 7) & 1)) * 16 + (row & 15)) * 4 + ((row >> 4) & 3); }
__device__ __forceinline__ float wave_max(float v) {
#pragma unroll
    for (int d = 1; d < 64; d <<= 1) v = fmaxf(v, __shfl_xor(v, d));
    return v; }
__device__ __forceinline__ void ssdnorm_row(const bf16* yraw, const bf16* H, const float* ng, unsigned char* ycat, unsigned char* say, int row, int lane) {
    v4u yv[8], zv[8];
#pragma unroll
    for (int g = 0; g < 8; ++g) { const int c = g * 512 + lane * 8; yv[g] = *(const v4u*)(yraw + (size_t)row * 4096 + c); zv[g] = *(const v4u*)(H + (size_t)row * LDH + C_Z + c); }
#pragma unroll
    for (int g = 0; g < 8; ++g) { const int c = g * 512 + lane * 8;
        float v[8] = {bflo(yv[g].x) * bflo(zv[g].x), bfhi(yv[g].x) * bfhi(zv[g].x), bflo(yv[g].y) * bflo(zv[g].y), bfhi(yv[g].y) * bfhi(zv[g].y),
                      bflo(yv[g].z) * bflo(zv[g].z), bfhi(yv[g].z) * bfhi(zv[g].z), bflo(yv[g].w) * bflo(zv[g].w), bfhi(yv[g].w) * bfhi(zv[g].w)};
        float ss = 0.f;
#pragma unroll
        for (int i = 0; i < 8; ++i) ss += v[i] * v[i];
        const float r = 1.f / sqrtf(wave_sum(ss) * (1.f / 512.f) + RMS_EPS);
        const f32x4 g0 = *(const f32x4*)(ng + c), g1 = *(const f32x4*)(ng + c + 4);
        float am = 0.f;
#pragma unroll
        for (int i = 0; i < 8; ++i) { v[i] = v[i] * r * (i < 4 ? g0[i] : g1[i - 4]); am = fmaxf(am, fabsf(v[i])); }
        const int sb = e8m0_of(wave_max(am)); const float inv = e8m0_inv(sb);
        *(v2u*)(ycat + (size_t)row * 6144 + c) = (v2u){pk4_fp8(v[0] * inv, v[1] * inv, v[2] * inv, v[3] * inv), pk4_fp8(v[4] * inv, v[5] * inv, v[6] * inv, v[7] * inv)};
        if (lane < 2) say[sa_idx(row, 2 * g + lane, 24)] = (unsigned char)sb; }
}
__device__ __forceinline__ void sgu_item(const bf16* H, const float* sg_w, const float* sg_b, unsigned char* ycat, unsigned char* say, int row, int quarter, int lane) {
    const int c = quarter * 512 + lane * 8, g = c >> 8;
    const int i = row >= TP ? ((row - TP) & 3) : (row & 127);
    const float* wrow = sg_w + ((size_t)g * 128 + i) * 128;
    float acc[8];
#pragma unroll
    for (int k = 0; k < 8; ++k) acc[k] = 0.f;
    const bf16* vp = H + (size_t)(row - i) * LDH + C_V + c;
    for (int j = 0; j <= i; ++j) { const float w = wrow[j]; const v4u x = *(const v4u*)(vp + (size_t)j * LDH);
        acc[0] += w * bflo(x.x); acc[1] += w * bfhi(x.x); acc[2] += w * bflo(x.y); acc[3] += w * bfhi(x.y); acc[4] += w * bflo(x.z); acc[5] += w * bfhi(x.z); acc[6] += w * bflo(x.w); acc[7] += w * bfhi(x.w); }
    const float bb = sg_b[g * 128 + i];
    const v4u u = *(const v4u*)(H + (size_t)row * LDH + C_U + c);
    float o[8] = {bflo(u.x) * (acc[0] + bb), bfhi(u.x) * (acc[1] + bb), bflo(u.y) * (acc[2] + bb), bfhi(u.y) * (acc[3] + bb), bflo(u.z) * (acc[4] + bb), bfhi(u.z) * (acc[5] + bb), bflo(u.w) * (acc[6] + bb), bfhi(u.w) * (acc[7] + bb)};
    float am = 0.f;
#pragma unroll
    for (int k = 0; k < 8; ++k) am = fmaxf(am, fabsf(o[k]));
#pragma unroll
    for (int d = 1; d < 32; d <<= 1) am = fmaxf(am, __shfl_xor(am, d));
    const int sb = e8m0_of(am); const float inv = e8m0_inv(sb);
    *(v2u*)(ycat + (size_t)row * 6144 + 4096 + c) = (v2u){pk4_fp8(o[0] * inv, o[1] * inv, o[2] * inv, o[3] * inv), pk4_fp8(o[4] * inv, o[5] * inv, o[6] * inv, o[7] * inv)};
    if ((lane & 31) == 0) say[sa_idx(row, 16 + g, 24)] = (unsigned char)sb;
}

typedef short s16x4 __attribute__((ext_vector_type(4)));
typedef short bf16x8 __attribute__((ext_vector_type(8)));
__device__ __forceinline__ unsigned off_b(unsigned row, unsigned ch) { return 256u * row + 16u * (ch ^ (((row & 3u) << 2) | ((row >> 2) & 3u))); }
__device__ __forceinline__ unsigned rr16(unsigned lane, unsigned rb, unsigned s) { return off_b((lane & 15u) + 16u * rb, 4u * s + (lane >> 4)); }
__device__ __forceinline__ unsigned tr16(unsigned lane, unsigned c, unsigned ks, unsigned t) { const unsigned g = lane >> 4, q = (lane & 15u) >> 2, p = lane & 3u;
    return off_b(32u * ks + 8u * g + 4u * t + q, 2u * c + (p >> 1)) + 8u * (p & 1u); }
__device__ __forceinline__ bf16x8 ld_row(const LAS unsigned char* p) { return *(const LAS bf16x8*)p; }
__device__ __forceinline__ s16x4 ld_tr4(const LAS unsigned char* p) { return __builtin_bit_cast(s16x4, __builtin_amdgcn_ds_read_tr16_b64_v4i16((LAS s16x4*)p)); }
__device__ __forceinline__ bf16x8 ld_tr(const LAS unsigned char* p0, const LAS unsigned char* p1) { const s16x4 a = ld_tr4(p0), b = ld_tr4(p1); return (bf16x8){a[0], a[1], a[2], a[3], b[0], b[1], b[2], b[3]}; }

__device__ __forceinline__ void sgu_unit(const bf16* H, const float* sg_w, const float* sg_b, unsigned char* ycat, unsigned char* say, int row0, int g, LAS unsigned char* lds, int tid) {
    const int lane = tid & 63, w = __builtin_amdgcn_readfirstlane(tid >> 6), q = lane >> 4, fr = lane & 15;
    LAS unsigned char* Wl = lds; LAS unsigned char* V0 = lds + 32768; LAS unsigned char* V1 = lds + 65536;
    __syncthreads();
#pragma unroll
    for (int k = 0; k < 4; ++k) { const int idx = tid + 512 * k, i = idx >> 4, ch = idx & 15, j0 = ch * 8;
        const float* sp = sg_w + ((size_t)g * 128 + i) * 128 + j0; const f32x4 a = *(const f32x4*)sp, b = *(const f32x4*)(sp + 4);
        v4u o; o.x = pk2(j0 + 0 <= i ? a[0] : 0.f, j0 + 1 <= i ? a[1] : 0.f); o.y = pk2(j0 + 2 <= i ? a[2] : 0.f, j0 + 3 <= i ? a[3] : 0.f);
        o.z = pk2(j0 + 4 <= i ? b[0] : 0.f, j0 + 5 <= i ? b[1] : 0.f); o.w = pk2(j0 + 6 <= i ? b[2] : 0.f, j0 + 7 <= i ? b[3] : 0.f);
        *(LAS v4u*)(Wl + off_b(i, ch)) = o; }
#pragma unroll
    for (int k = 0; k < 8; ++k) { const int idx = tid + 512 * k, j = idx >> 5, c32 = idx & 31;
        const v4u v = *(const v4u*)(H + (size_t)(row0 + j) * LDH + C_V + g * 256 + c32 * 8);
        *(LAS v4u*)((c32 < 16 ? V0 : V1) + off_b(j, c32 & 15)) = v; }
    __syncthreads();
    const int I = w;
    bf16x8 wf[4];
#pragma unroll
    for (int ks = 0; ks < 4; ++ks) wf[ks] = ld_row(Wl + rr16(lane, I, ks));
    const int irow = row0 + 16 * I + fr; const float bias = sg_b[g * 128 + 16 * I + fr];
    f32x4 o[16]; float am = 0.f;
#pragma unroll
    for (int dt = 0; dt < 16; ++dt) {
        const LAS unsigned char* Vi = dt < 8 ? V0 : V1; const int c = dt & 7;
        f32x4 acc = (f32x4){0.f, 0.f, 0.f, 0.f};
#pragma unroll
        for (int ks = 0; ks < 4; ++ks) { const bf16x8 a = ld_tr(Vi + tr16(lane, c, ks, 0), Vi + tr16(lane, c, ks, 1)); acc = __builtin_amdgcn_mfma_f32_16x16x32_bf16(a, wf[ks], acc, 0, 0, 0); }
        const int col = g * 256 + 16 * dt + 4 * q;
        const v2u u = *(const v2u*)(H + (size_t)irow * LDH + C_U + col);
        o[dt] = (f32x4){bflo(u.x) * (acc[0] + bias), bfhi(u.x) * (acc[1] + bias), bflo(u.y) * (acc[2] + bias), bfhi(u.y) * (acc[3] + bias)};
        am = fmaxf(fmaxf(am, fmaxf(fabsf(o[dt][0]), fabsf(o[dt][1]))), fmaxf(fabsf(o[dt][2]), fabsf(o[dt][3])));
    }
    am = fmaxf(am, __shfl_xor(am, 16)); am = fmaxf(am, __shfl_xor(am, 32));
    const int sb = e8m0_of(am); const float inv = e8m0_inv(sb);
#pragma unroll
    for (int dt = 0; dt < 16; ++dt) *(unsigned*)(ycat + (size_t)irow * 6144 + 4096 + g * 256 + 16 * dt + 4 * q) = pk4_fp8(o[dt][0] * inv, o[dt][1] * inv, o[dt][2] * inv, o[dt][3] * inv);
    if (q == 0) say[sa_idx(irow, 16 + g, 24)] = (unsigned char)sb;
}

__device__ __forceinline__ unsigned off_x(unsigned j, unsigned ch) { const unsigned g = ((j >> 1) & 1u) | ((((j >> 2) ^ (j >> 3)) & 1u) << 1); return 128u * j + 16u * (ch ^ (2u * g)); }
__device__ __forceinline__ unsigned trx(unsigned lane, unsigned tp, unsigned rowbase) { return off_x(rowbase + ((lane & 15u) >> 2), 2u * tp + ((lane & 3u) >> 1)) + 8u * (lane & 1u); }
struct SmpArgs { const float* sin; float* sout; const float* a_log; const float* d_skip; int bg0; int fuse; };
__device__ __forceinline__ void ssd_chunk_unit(const bf16* xbcc, const float* dtb, int b, int h, float a, float Dk, bf16* yraw, float* sout, LAS unsigned char* lds, int tid, const SmpArgs sm) {
    const int lane = tid & 63, w = __builtin_amdgcn_readfirstlane(tid >> 6), q0 = lane >> 4, fr0 = lane & 15, g = h >> 3;
    const int I = w < 4 ? w : 11 - w;
    LAS unsigned char* Xl = lds; LAS unsigned char* Xsl = lds + 16384; LAS unsigned char* Bl = lds + 32768; LAS unsigned char* Cl = lds + 65536; LAS unsigned char* Sl = lds + 98304;
    LAS float* tab = (LAS float*)(lds + 114688);
    const int row0 = b * 2048;
    LAS unsigned char* smp = lds + 118784;
#define SMP_STAGE(jj) do { if (sm.fuse && tid < 128) { const int bg_ = sm.bg0 + 256 * (jj), t_ = tid >> 5, part_ = (tid >> 4) & 1, ch_ = tid & 15; \
        *(LAS v4u*)(smp + (t_ * 2 + part_) * 256 + ch_ * 16) = *(const v4u*)(xbcc + (size_t)(TP + 4 * (bg_ >> 3) + t_) * 6144 + (part_ ? 5120 : 4096) + (bg_ & 7) * 128 + ch_ * 8); } } while (0)
#define SMP_LOAD(cc) do { const int bg_ = sm.bg0 + 256 * ((cc) >> 2), p_ = w * 8 + (lane >> 3), ng_ = lane & 7; \
        _Pragma("unroll") for (int hh = 0; hh < 2; ++hh) { const int hs_ = (bg_ & 7) * 8 + 2 * ((cc) & 3) + hh; const f32x4* sp_ = (const f32x4*)(sm.sin + (size_t)((bg_ >> 3) * 64 + hs_) * 8192 + (size_t)p_ * 128 + ng_ * 16); \
            _Pragma("unroll") for (int k = 0; k < 4; ++k) sst[hh][k] = sp_[k]; } } while (0)
#define WG_BAR() do { LDS_WAIT(); __builtin_amdgcn_s_barrier(); asm volatile("" ::: "memory"); } while (0)
    f32x4 sst[2][4];
    v4u rx[2], rb[4], rc[4];
    f32x4 accS[4];
#pragma unroll
    for (int tp = 0; tp < 4; ++tp) accS[tp] = (f32x4){0.f, 0.f, 0.f, 0.f};
    __syncthreads();
#pragma unroll
    for (int k = 0; k < 2; ++k) *(LAS v4u*)(Sl + (tid + 512 * k) * 16) = (v4u){0u, 0u, 0u, 0u};
#define SSD_LOAD(cc) do { const bf16* base_ = xbcc + (size_t)(row0 + (cc) * 128) * 6144; \
        _Pragma("unroll") for (int k = 0; k < 2; ++k) { const int idx = (int)tq + 512 * k; rx[k] = *(const v4u*)(base_ + (size_t)(idx >> 3) * 6144 + h * 64 + (idx & 7) * 8); } \
        _Pragma("unroll") for (int k = 0; k < 4; ++k) { const int idx = (int)tq + 512 * k; rb[k] = *(const v4u*)(base_ + (size_t)(idx >> 4) * 6144 + 4096 + g * 128 + (idx & 15) * 8); \
                                                         rc[k] = *(const v4u*)(base_ + (size_t)(idx >> 4) * 6144 + 5120 + g * 128 + (idx & 15) * 8); } } while (0)
#define SSD_TABLE(cc) do { if (w == 0) { LAS float* tb_ = tab + ((cc) & 1) * 388; const float* dp_ = dtb + (size_t)(row0 + (cc) * 128) * 64 + h; \
        const float d0 = dp_[(size_t)lane * 64], d1 = dp_[(size_t)(lane + 64) * 64]; float s0 = d0 * a, s1 = d1 * a; \
        _Pragma("unroll") for (int o = 1; o < 64; o <<= 1) { const float t0 = __shfl_up(s0, o), t1 = __shfl_up(s1, o); if (lane >= o) { s0 += t0; s1 += t1; } } \
        s1 += __shfl(s0, 63); const float aend = __shfl(s1, 63); \
        tb_[lane] = s0; tb_[lane + 64] = s1; tb_[128 + lane] = d0; tb_[192 + lane] = d1; tb_[256 + lane] = __expf(aend - s0) * d0; tb_[320 + lane] = __expf(aend - s1) * d1; if (lane == 0) tb_[384] = __expf(aend); } } while (0)
#define SSD_STORE(cc) do { const LAS float* te_ = tab + ((cc) & 1) * 388 + 256; \
        _Pragma("unroll") for (int k = 0; k < 2; ++k) { const int idx = (int)tq + 512 * k, j = idx >> 3, ch = idx & 7; *(LAS v4u*)(Xl + off_x(j, ch)) = rx[k]; const float t = te_[j]; \
            v4u o; o.x = pk2(bflo(rx[k].x) * t, bfhi(rx[k].x) * t); o.y = pk2(bflo(rx[k].y) * t, bfhi(rx[k].y) * t); o.z = pk2(bflo(rx[k].z) * t, bfhi(rx[k].z) * t); o.w = pk2(bflo(rx[k].w) * t, bfhi(rx[k].w) * t); \
            *(LAS v4u*)(Xsl + off_x(j, ch)) = o; } \
        _Pragma("unroll") for (int k = 0; k < 4; ++k) { const int idx = (int)tq + 512 * k, j = idx >> 4, ch = idx & 15; *(LAS v4u*)(Bl + off_b(j, ch)) = rb[k]; *(LAS v4u*)(Cl + off_b(j, ch)) = rc[k]; } } while (0)
    unsigned tq = (unsigned)tid; asm volatile("" : "+v"(tq));
    SSD_LOAD(0); SSD_TABLE(0);
    if (sm.fuse) SMP_LOAD(0);
    __syncthreads();
    SSD_STORE(0); SMP_STAGE(0);
    __syncthreads();
    for (int c = 0; c < 16; ++c) {
        unsigned ln = (unsigned)lane; asm volatile("" : "+v"(ln), "+v"(tq)); const int q = (int)(ln >> 4), fr = (int)(ln & 15u);
        if (c + 1 < 16) SSD_TABLE(c + 1);
        const LAS float* tb = tab + (c & 1) * 388;
        bf16x8 cf[4];
        f32x4 accY[4];
        float ai, ei;
        { bf16x8 sf[4][4];
#pragma unroll
          for (int s = 0; s < 4; ++s) cf[s] = ld_row(Cl + rr16(ln, I, s));
#pragma unroll
          for (int s = 0; s < 4; ++s)
#pragma unroll
              for (int tp = 0; tp < 4; ++tp) sf[s][tp] = ld_row(Sl + rr16(ln, tp, s));
          ai = tb[16 * I + fr];
          LDS_WAIT();
          ei = __expf(ai);
#pragma unroll
          for (int tp = 0; tp < 4; ++tp) accY[tp] = (f32x4){0.f, 0.f, 0.f, 0.f};
#pragma unroll
          for (int s = 0; s < 4; ++s)
#pragma unroll
              for (int tp = 0; tp < 4; ++tp) accY[tp] = __builtin_amdgcn_mfma_f32_16x16x32_bf16(sf[s][tp], cf[s], accY[tp], 0, 0, 0);
#pragma unroll
          for (int tp = 0; tp < 4; ++tp) accY[tp] = accY[tp] * ei; }
#pragma unroll
        for (int s = 0; s < 4; ++s) if (2 * s <= I) {
            const bool two = (2 * s + 1 <= I);
            bf16x8 b0f[4], b1f[4], xt[4];
#pragma unroll
            for (int sn = 0; sn < 4; ++sn) b0f[sn] = ld_row(Bl + rr16(ln, 2 * s, sn));
            if (two) {
#pragma unroll
                for (int sn = 0; sn < 4; ++sn) b1f[sn] = ld_row(Bl + rr16(ln, 2 * s + 1, sn)); }
#pragma unroll
            for (int tp = 0; tp < 4; ++tp) xt[tp] = ld_tr(Xl + trx(ln, tp, 32 * s + 4 * q), Xl + trx(ln, tp, 32 * s + 16 + 4 * q));
            const f32x4 aj0 = *(const LAS f32x4*)(tb + 32 * s + 4 * q), dj0 = *(const LAS f32x4*)(tb + 128 + 32 * s + 4 * q);
            const f32x4 aj1 = *(const LAS f32x4*)(tb + 32 * s + 16 + 4 * q), dj1 = *(const LAS f32x4*)(tb + 128 + 32 * s + 16 + 4 * q);
            LDS_WAIT();
            f32x4 g0 = (f32x4){0.f, 0.f, 0.f, 0.f}, g1 = (f32x4){0.f, 0.f, 0.f, 0.f};
#pragma unroll
            for (int sn = 0; sn < 4; ++sn) g0 = __builtin_amdgcn_mfma_f32_16x16x32_bf16(b0f[sn], cf[sn], g0, 0, 0, 0);
            if (two) {
#pragma unroll
                for (int sn = 0; sn < 4; ++sn) g1 = __builtin_amdgcn_mfma_f32_16x16x32_bf16(b1f[sn], cf[sn], g1, 0, 0, 0); }
#pragma unroll
            for (int r = 0; r < 4; ++r) { const float v = g0[r] * __expf(ai - aj0[r]) * dj0[r]; g0[r] = (2 * s < I || 4 * q + r <= fr) ? v : 0.f; }
            if (two) {
#pragma unroll
                for (int r = 0; r < 4; ++r) { const float v = g1[r] * __expf(ai - aj1[r]) * dj1[r]; g1[r] = (2 * s + 1 < I || 4 * q + r <= fr) ? v : 0.f; } }
            v4u lw; lw.x = pk2(g0[0], g0[1]); lw.y = pk2(g0[2], g0[3]); lw.z = pk2(g1[0], g1[1]); lw.w = pk2(g1[2], g1[3]);
            const bf16x8 lf = __builtin_bit_cast(bf16x8, lw);
#pragma unroll
            for (int tp = 0; tp < 4; ++tp) accY[tp] = __builtin_amdgcn_mfma_f32_16x16x32_bf16(xt[tp], lf, accY[tp], 0, 0, 0);
        }
        { const int il = 16 * I + fr; bf16* yp = yraw + (size_t)(row0 + c * 128 + il) * 4096 + h * 64 + 4 * q;
#pragma unroll
          for (int tp = 0; tp < 4; ++tp) { const v2u xw = *(const LAS v2u*)(Xl + off_x(il, 2 * tp + (q >> 1)) + 8 * (q & 1));
              const f32x4 yv = accY[tp] + (f32x4){bflo(xw.x), bfhi(xw.x), bflo(xw.y), bfhi(xw.y)} * Dk;
              v2u o; o.x = pk2(yv[0], yv[1]); o.y = pk2(yv[2], yv[3]); *(v2u*)(yp + 16 * tp) = o; } }
        if (c + 1 < 16) SSD_LOAD(c + 1);
        { bf16x8 bt[4], xs[4][4];
#pragma unroll
          for (int ks = 0; ks < 4; ++ks) bt[ks] = ld_tr(Bl + tr16(ln, w, ks, 0), Bl + tr16(ln, w, ks, 1));
#pragma unroll
          for (int ks = 0; ks < 4; ++ks)
#pragma unroll
              for (int tp = 0; tp < 4; ++tp) xs[ks][tp] = ld_tr(Xsl + trx(ln, tp, 32 * ks + 8 * q), Xsl + trx(ln, tp, 32 * ks + 8 * q + 4));
          const float cd = tb[384];
          LDS_WAIT();
#pragma unroll
          for (int tp = 0; tp < 4; ++tp) accS[tp] = accS[tp] * cd;
#pragma unroll
          for (int ks = 0; ks < 4; ++ks)
#pragma unroll
              for (int tp = 0; tp < 4; ++tp) accS[tp] = __builtin_amdgcn_mfma_f32_16x16x32_bf16(xs[ks][tp], bt[ks], accS[tp], 0, 0, 0); }
        if (sm.fuse) {
            const int sbg = sm.bg0 + 256 * (c >> 2), sb = sbg >> 3, sg = sbg & 7, sp = w * 8 + (int)(ln >> 3), sng = (int)(ln & 7u), srow0 = TP + 4 * sb;
            float sxv[2][4], sdt[2][4];
#pragma unroll
            for (int hh = 0; hh < 2; ++hh) { const int hs_ = sg * 8 + 2 * (c & 3) + hh;
#pragma unroll
                for (int t = 0; t < 4; ++t) { sxv[hh][t] = __builtin_bit_cast(float, (unsigned)xbcc[(size_t)(srow0 + t) * 6144 + hs_ * 64 + sp] << 16); sdt[hh][t] = dtb[(size_t)(srow0 + t) * 64 + hs_]; } }
#pragma unroll
            for (int hh = 0; hh < 2; ++hh) { const int hs_ = sg * 8 + 2 * (c & 3) + hh; const float sa = -__expf(sm.a_log[hs_]), sD = sm.d_skip[hs_];
                float hst[16];
#pragma unroll
                for (int k = 0; k < 4; ++k) { hst[4 * k] = sst[hh][k][0]; hst[4 * k + 1] = sst[hh][k][1]; hst[4 * k + 2] = sst[hh][k][2]; hst[4 * k + 3] = sst[hh][k][3]; }
#pragma unroll
                for (int t = 0; t < 4; ++t) {
                    const v4u b0 = *(const LAS v4u*)(smp + (t * 2) * 256 + sng * 32), b1 = *(const LAS v4u*)(smp + (t * 2) * 256 + sng * 32 + 16);
                    const v4u c0 = *(const LAS v4u*)(smp + (t * 2 + 1) * 256 + sng * 32), c1 = *(const LAS v4u*)(smp + (t * 2 + 1) * 256 + sng * 32 + 16);
                    const unsigned bb[8] = {b0.x, b0.y, b0.z, b0.w, b1.x, b1.y, b1.z, b1.w}, cc[8] = {c0.x, c0.y, c0.z, c0.w, c1.x, c1.y, c1.z, c1.w};
                    const float dA = __expf(sdt[hh][t] * sa), xdt = sxv[hh][t] * sdt[hh][t];
                    float y = 0.f;
#pragma unroll
                    for (int i = 0; i < 8; ++i) {
                        hst[2 * i] = hst[2 * i] * dA + xdt * bflo(bb[i]); y += hst[2 * i] * bflo(cc[i]);
                        hst[2 * i + 1] = hst[2 * i + 1] * dA + xdt * bfhi(bb[i]); y += hst[2 * i + 1] * bfhi(cc[i]); }
                    y += __shfl_xor(y, 1); y += __shfl_xor(y, 2); y += __shfl_xor(y, 4);
                    if (sng == 0) yraw[(size_t)(srow0 + t) * 4096 + hs_ * 64 + sp] = (bf16)f2bf(y + sD * sxv[hh][t]);
                    asm volatile("" ::: "memory");
                }
                f32x4* so_ = (f32x4*)(sm.sout + (size_t)(sb * 64 + hs_) * 8192 + (size_t)sp * 128 + sng * 16);
#pragma unroll
                for (int k = 0; k < 4; ++k) so_[k] = (f32x4){hst[4 * k], hst[4 * k + 1], hst[4 * k + 2], hst[4 * k + 3]}; }
            if (c + 1 < 16) SMP_LOAD(c + 1);
        }
        WG_BAR();
#pragma unroll
        for (int tp = 0; tp < 4; ++tp)
#pragma unroll
            for (int r = 0; r < 4; ++r) { const unsigned p = 16 * tp + 4 * q + r, n = 16 * w + fr; *(LAS unsigned short*)(Sl + off_b(p, n >> 3) + (n & 7) * 2) = (unsigned short)f2bf(accS[tp][r]); }
        if (c + 1 < 16) SSD_STORE(c + 1);
        if ((c & 3) == 3 && c + 1 < 16) SMP_STAGE((c + 1) >> 2);
        WG_BAR();
    }
#pragma unroll
    for (int tp = 0; tp < 4; ++tp)
#pragma unroll
        for (int r = 0; r < 4; ++r) sout[(size_t)(16 * tp + 4 * q0 + r) * 128 + 16 * w + fr0] = accS[tp][r];
#undef SSD_LOAD
#undef SSD_TABLE
#undef SSD_STORE
#undef SMP_STAGE
#undef SMP_LOAD
#undef WG_BAR
}

__device__ __forceinline__ void ssd_sample_wave(const bf16* xbcc, const float* dtb, const float* sin, float* sout, bf16* yraw, const float* a_log, const float* d_skip, int wu, f32x4 (&st)[4], int wu_next, int lane) {
    const int v = wu >> 3, p = (wu & 7) * 8 + (lane >> 3), ng = lane & 7, b = v >> 6, h = v & 63, g = h >> 3;
    f32x4 nx[4];
    if (wu_next >= 0) { const float* sp = sin + (size_t)(wu_next >> 3) * 8192 + (size_t)((wu_next & 7) * 8 + (lane >> 3)) * 128 + ng * 16;
#pragma unroll
        for (int k = 0; k < 4; ++k) nx[k] = *(const f32x4*)(sp + 4 * k); }
    const float a = -__expf(a_log[h]), Dk = d_skip[h];
    const int row0 = TP + b * 4;
    float hs[16];
#pragma unroll
    for (int k = 0; k < 4; ++k) { hs[4 * k] = st[k][0]; hs[4 * k + 1] = st[k][1]; hs[4 * k + 2] = st[k][2]; hs[4 * k + 3] = st[k][3]; }
    v4u bw[4][2], cw[4][2]; float xv[4], dtv[4];
#pragma unroll
    for (int t = 0; t < 4; ++t) { const bf16* rp = xbcc + (size_t)(row0 + t) * 6144;
        bw[t][0] = *(const v4u*)(rp + 4096 + g * 128 + ng * 16); bw[t][1] = *(const v4u*)(rp + 4096 + g * 128 + ng * 16 + 8);
        cw[t][0] = *(const v4u*)(rp + 5120 + g * 128 + ng * 16); cw[t][1] = *(const v4u*)(rp + 5120 + g * 128 + ng * 16 + 8);
        xv[t] = __builtin_bit_cast(float, (unsigned)rp[h * 64 + p] << 16); dtv[t] = dtb[(size_t)(row0 + t) * 64 + h]; }
#pragma unroll
    for (int t = 0; t < 4; ++t) {
        const float dA = __expf(dtv[t] * a), xdt = xv[t] * dtv[t];
        const unsigned bb[8] = {bw[t][0].x, bw[t][0].y, bw[t][0].z, bw[t][0].w, bw[t][1].x, bw[t][1].y, bw[t][1].z, bw[t][1].w};
        const unsigned cc[8] = {cw[t][0].x, cw[t][0].y, cw[t][0].z, cw[t][0].w, cw[t][1].x, cw[t][1].y, cw[t][1].z, cw[t][1].w};
        float y = 0.f;
#pragma unroll
        for (int i = 0; i < 8; ++i) {
            hs[2 * i] = hs[2 * i] * dA + xdt * bflo(bb[i]); y += hs[2 * i] * bflo(cc[i]);
            hs[2 * i + 1] = hs[2 * i + 1] * dA + xdt * bfhi(bb[i]); y += hs[2 * i + 1] * bfhi(cc[i]); }
        y += __shfl_xor(y, 1); y += __shfl_xor(y, 2); y += __shfl_xor(y, 4);
        if (ng == 0) yraw[(size_t)(row0 + t) * 4096 + h * 64 + p] = (bf16)f2bf(y + Dk * xv[t]);
    }
    { float* sp = sout + (size_t)v * 8192 + (size_t)p * 128 + ng * 16;
#pragma unroll
      for (int k = 0; k < 4; ++k) *(f32x4*)(sp + 4 * k) = (f32x4){hs[4 * k], hs[4 * k + 1], hs[4 * k + 2], hs[4 * k + 3]}; }
    if (wu_next >= 0) {
#pragma unroll
        for (int k = 0; k < 4; ++k) st[k] = nx[k]; }
}

__device__ __forceinline__ void ssd_sample_bg(const bf16* xbcc, const float* dtb, const float* sin, float* sout, bf16* yraw, const float* a_log, const float* d_skip, int bg, int wave, int lane) {
    const int b = bg >> 3, g = bg & 7, p = wave * 8 + (lane >> 3), ng = lane & 7, row0 = TP + b * 4;
    unsigned bb[4][8], cc[4][8];
#pragma unroll
    for (int t = 0; t < 4; ++t) { const bf16* rp = xbcc + (size_t)(row0 + t) * 6144 + g * 128 + ng * 16;
        const v4u b0 = *(const v4u*)(rp + 4096), b1 = *(const v4u*)(rp + 4096 + 8), c0 = *(const v4u*)(rp + 5120), c1 = *(const v4u*)(rp + 5120 + 8);
        bb[t][0] = b0.x; bb[t][1] = b0.y; bb[t][2] = b0.z; bb[t][3] = b0.w; bb[t][4] = b1.x; bb[t][5] = b1.y; bb[t][6] = b1.z; bb[t][7] = b1.w;
        cc[t][0] = c0.x; cc[t][1] = c0.y; cc[t][2] = c0.z; cc[t][3] = c0.w; cc[t][4] = c1.x; cc[t][5] = c1.y; cc[t][6] = c1.z; cc[t][7] = c1.w; }
    const size_t soff = (size_t)p * 128 + ng * 16;
    f32x4 st[4], nx[4]; float xv[4], dtv[4], xn[4], dn[4];
#define SB_LOAD(ST, XV, DT, hh_) do { const int h_ = g * 8 + (hh_); const f32x4* sp_ = (const f32x4*)(sin + (size_t)(b * 64 + h_) * 8192 + soff); \
        _Pragma("unroll") for (int k = 0; k < 4; ++k) ST[k] = sp_[k]; \
        _Pragma("unroll") for (int t = 0; t < 4; ++t) { XV[t] = __builtin_bit_cast(float, (unsigned)xbcc[(size_t)(row0 + t) * 6144 + h_ * 64 + p] << 16); DT[t] = dtb[(size_t)(row0 + t) * 64 + h_]; } } while (0)
#define SB_STEP(ST, XV, DT, NST, NXV, NDT, hh_) do { \
        if ((hh_) < 7) SB_LOAD(NST, NXV, NDT, (hh_) + 1); \
        const int h_ = g * 8 + (hh_); const float a_ = -__expf(a_log[h_]), D_ = d_skip[h_]; \
        float hs[16]; _Pragma("unroll") for (int k = 0; k < 4; ++k) { hs[4 * k] = ST[k][0]; hs[4 * k + 1] = ST[k][1]; hs[4 * k + 2] = ST[k][2]; hs[4 * k + 3] = ST[k][3]; } \
        _Pragma("unroll") for (int t = 0; t < 4; ++t) { const float dA = __expf(DT[t] * a_), xdt = XV[t] * DT[t]; float y = 0.f; \
            _Pragma("unroll") for (int i = 0; i < 8; ++i) { hs[2 * i] = hs[2 * i] * dA + xdt * bflo(bb[t][i]); y += hs[2 * i] * bflo(cc[t][i]); hs[2 * i + 1] = hs[2 * i + 1] * dA + xdt * bfhi(bb[t][i]); y += hs[2 * i + 1] * bfhi(cc[t][i]); } \
            y += __shfl_xor(y, 1); y += __shfl_xor(y, 2); y += __shfl_xor(y, 4); \
            if (ng == 0) yraw[(size_t)(row0 + t) * 4096 + h_ * 64 + p] = (bf16)f2bf(y + D_ * XV[t]); } \
        f32x4* so_ = (f32x4*)(sout + (size_t)(b * 64 + h_) * 8192 + soff); \
        _Pragma("unroll") for (int k = 0; k < 4; ++k) so_[k] = (f32x4){hs[4 * k], hs[4 * k + 1], hs[4 * k + 2], hs[4 * k + 3]}; } while (0)
    SB_LOAD(st, xv, dtv, 0);
    for (int h2 = 0; h2 < 8; h2 += 2) { SB_STEP(st, xv, dtv, nx, xn, dn, h2); SB_STEP(nx, xn, dn, st, xv, dtv, h2 + 1); }
#undef SB_LOAD
#undef SB_STEP
}

struct P7Args { const bf16* r1b; bf16* x1lo; bf16* x1b; const float *ln_g, *ln_b, *b_rg, *b_re; const v4u* wrf; unsigned* cnt; int* grp; int* rank; float* gw; };
__device__ __forceinline__ void ln1_row(const P7Args& a, int row, int lane) {
    const bf16* rp = a.r1b + (size_t)row * 4096;
    float v[64]; float s = 0.f;
#pragma unroll
    for (int j = 0; j < 8; ++j) { const v4u w = *(const v4u*)(rp + (lane + 64 * j) * 8);
        v[8 * j] = bflo(w.x); v[8 * j + 1] = bfhi(w.x); v[8 * j + 2] = bflo(w.y); v[8 * j + 3] = bfhi(w.y); v[8 * j + 4] = bflo(w.z); v[8 * j + 5] = bfhi(w.z); v[8 * j + 6] = bflo(w.w); v[8 * j + 7] = bfhi(w.w); }
#pragma unroll
    for (int i = 0; i < 64; ++i) s += v[i];
    const float mean = wave_sum(s) * (1.f / 4096.f); float s2 = 0.f;
#pragma unroll
    for (int i = 0; i < 64; ++i) { v[i] -= mean; s2 += v[i] * v[i]; }
    const float rstd = 1.f / sqrtf(wave_sum(s2) * (1.f / 4096.f) + LN_EPS);
#pragma unroll
    for (int j = 0; j < 8; ++j) { const int c = (lane + 64 * j) * 8;
        const f32x4 g0 = *(const f32x4*)(a.ln_g + c), g1 = *(const f32x4*)(a.ln_g + c + 4), b0 = *(const f32x4*)(a.ln_b + c), b1 = *(const f32x4*)(a.ln_b + c + 4);
        f32x4 o0, o1;
#pragma unroll
        for (int i = 0; i < 4; ++i) { o0[i] = v[8 * j + i] * rstd * g0[i] + b0[i]; o1[i] = v[8 * j + 4 + i] * rstd * g1[i] + b1[i]; }
        v4u w; w.x = pk2(o0[0], o0[1]); w.y = pk2(o0[2], o0[3]); w.z = pk2(o1[0], o1[1]); w.w = pk2(o1[2], o1[3]);
        v4u l; l.x = pk2(o0[0] - bflo(w.x), o0[1] - bfhi(w.x)); l.y = pk2(o0[2] - bflo(w.y), o0[3] - bfhi(w.y)); l.z = pk2(o1[0] - bflo(w.z), o1[1] - bfhi(w.z)); l.w = pk2(o1[2] - bflo(w.w), o1[3] - bfhi(w.w));
        *(v4u*)(a.x1b + (size_t)row * 4096 + c) = w; *(v4u*)(a.x1lo + (size_t)row * 4096 + c) = l; }
}
__device__ __forceinline__ void router_tile(const P7Args& a, int row0, int nvalid, LAS float* lg, int lane) {
    const int fr = lane & 15, q = lane >> 4;
    const size_t xoff = (size_t)(row0 + (fr < nvalid ? fr : 0)) * 4096 + 8 * q;
    f32x4 acc[3];
#pragma unroll
    for (int c = 0; c < 3; ++c) acc[c] = (f32x4){0.f, 0.f, 0.f, 0.f};
#pragma unroll 2
    for (int sk = 0; sk < 128; ++sk) {
        const bf16x8 ah = __builtin_bit_cast(bf16x8, *(const v4u*)(a.x1b + xoff + 32 * sk)), al = __builtin_bit_cast(bf16x8, *(const v4u*)(a.x1lo + xoff + 32 * sk));
        const v4u* wf = a.wrf + (size_t)sk * 6 * 64 + lane;
#pragma unroll
        for (int c = 0; c < 3; ++c) { const bf16x8 wh = __builtin_bit_cast(bf16x8, wf[(2 * c) * 64]), wl = __builtin_bit_cast(bf16x8, wf[(2 * c + 1) * 64]);
            acc[c] = __builtin_amdgcn_mfma_f32_16x16x32_bf16(ah, wh, acc[c], 0, 0, 0);
            acc[c] = __builtin_amdgcn_mfma_f32_16x16x32_bf16(al, wh, acc[c], 0, 0, 0);
            acc[c] = __builtin_amdgcn_mfma_f32_16x16x32_bf16(ah, wl, acc[c], 0, 0, 0); }
    }
#pragma unroll
    for (int c = 0; c < 3; ++c)
#pragma unroll
        for (int r = 0; r < 4; ++r) lg[(4 * q + r) * 48 + 16 * c + fr] = acc[c][r];
    LDS_WAIT(); asm volatile("" ::: "memory");
    if (lane < nvalid) {
        const LAS float* L = lg + lane * 48; const int row = row0 + lane;
        float gl[8];
#pragma unroll
        for (int j = 0; j < 8; ++j) gl[j] = L[32 + j] + a.b_rg[j];
        int grp = 0; float gmax = gl[0];
#pragma unroll
        for (int j = 1; j < 8; ++j) if (gl[j] > gmax) { gmax = gl[j]; grp = j; }
        float den = 0.f;
#pragma unroll
        for (int j = 0; j < 8; ++j) den += __expf(gl[j] - gmax);
        const float pgrp = 1.f / den;
        float ev[4];
#pragma unroll
        for (int k = 0; k < 4; ++k) ev[k] = L[grp * 4 + k] + a.b_re[grp * 4 + k];
        int i1 = 0; float v1 = ev[0];
#pragma unroll
        for (int k = 1; k < 4; ++k) if (ev[k] > v1) { v1 = ev[k]; i1 = k; }
        int i2 = -1; float v2 = -3.0e38f;
#pragma unroll
        for (int k = 0; k < 4; ++k) if (k != i1 && ev[k] > v2) { v2 = ev[k]; i2 = k; }
        const float e = __expf(v2 - v1), w1 = pgrp / (1.f + e), w2 = pgrp * e / (1.f + e);
        const unsigned rk = atomicAdd(a.cnt + grp, 1u);
        a.grp[row] = grp; a.rank[row] = (int)rk;
        *(f32x4*)(a.gw + (size_t)row * 4) = (f32x4){i1 == 0 ? w1 : (i2 == 0 ? w2 : 0.f), i1 == 1 ? w1 : (i2 == 1 ? w2 : 0.f), i1 == 2 ? w1 : (i2 == 2 ? w2 : 0.f), i1 == 3 ? w1 : (i2 == 3 ? w2 : 0.f)};
    }
    LDS_WAIT(); asm volatile("" ::: "memory");
}

__device__ __forceinline__ void p8_sort(const bf16* x1b, const unsigned* cnt, const int* grp, const int* rank, const float* gw, unsigned char* xg, unsigned char* sax, int* tokmap, float* gws, int gwv, int NGW, int lane) {
    int tb[9]; tb[0] = 0;
#pragma unroll
    for (int g = 0; g < 8; ++g) tb[g + 1] = tb[g] + (int)((cnt[g] + 255u) >> 8);
    for (int row = gwv; row < T; row += NGW) {
        const int g = grp[row]; int base = 0;
#pragma unroll
        for (int k = 0; k < 8; ++k) base = (g == k) ? tb[k] : base;
        const size_t pos = (size_t)base * 256 + rank[row];
        const v4u* s = (const v4u*)(x1b + (size_t)row * 4096); v2u* d = (v2u*)(xg + pos * 4096);
        v4u w[8]; float am = 0.f;
#pragma unroll
        for (int j = 0; j < 8; ++j) w[j] = s[lane + 64 * j];
#pragma unroll
        for (int j = 0; j < 8; ++j) am = fmaxf(fmaxf(fmaxf(am, fmaxf(fabsf(bflo(w[j].x)), fabsf(bfhi(w[j].x)))), fmaxf(fabsf(bflo(w[j].y)), fabsf(bfhi(w[j].y)))),
                                                fmaxf(fmaxf(fabsf(bflo(w[j].z)), fabsf(bfhi(w[j].z))), fmaxf(fabsf(bflo(w[j].w)), fabsf(bfhi(w[j].w)))));
#pragma unroll
        for (int dd = 1; dd < 64; dd <<= 1) am = fmaxf(am, __shfl_xor(am, dd));
        const int sb = e8m0_of(am); const float inv = e8m0_inv(sb);
#pragma unroll
        for (int j = 0; j < 8; ++j) { v2u q; q.x = pk4_fp8(bflo(w[j].x) * inv, bfhi(w[j].x) * inv, bflo(w[j].y) * inv, bfhi(w[j].y) * inv); q.y = pk4_fp8(bflo(w[j].z) * inv, bfhi(w[j].z) * inv, bflo(w[j].w) * inv, bfhi(w[j].w) * inv);
            d[lane + 64 * j] = q; }
        if (lane == 0) { const int pr = (int)pos; tokmap[pos] = row; *(f32x4*)(gws + pos * 4) = *(const f32x4*)(gw + (size_t)row * 4);
            sax[(((((pr >> 8) * 2 + ((pr >> 6) & 1)) * 2 + ((pr >> 7) & 1)) * 16 + (pr & 15)) * 4) + ((pr >> 4) & 3)] = (unsigned char)sb; }
    }
    for (int idx = gwv; idx < 8 * 256; idx += NGW) {
        const int g = idx >> 8; int base = 0, n = 0, c = 0;
#pragma unroll
        for (int k = 0; k < 8; ++k) { base = (g == k) ? tb[k] : base; n = (g == k) ? tb[k + 1] - tb[k] : n; c = (g == k) ? (int)cnt[k] : c; }
        const int r = c + (idx & 255);
        if (r < n * 256) { const size_t pos = (size_t)base * 256 + r; v2u* d = (v2u*)(xg + pos * 4096);
#pragma unroll
            for (int j = 0; j < 8; ++j) d[lane + 64 * j] = (v2u){0u, 0u};
            if (lane == 0) { const int pr = (int)pos; tokmap[pos] = -1; *(f32x4*)(gws + pos * 4) = (f32x4){0.f, 0.f, 0.f, 0.f};
                sax[(((((pr >> 8) * 2 + ((pr >> 6) & 1)) * 2 + ((pr >> 7) & 1)) * 16 + (pr & 15)) * 4) + ((pr >> 4) & 3)] = (unsigned char)127; } }
    }
}

__device__ __forceinline__ void ln2_row(const bf16* r2, const float* g, const float* b, float* out, int row, int lane) {
    const bf16* rp = r2 + (size_t)row * 4096;
    float v[64]; float s = 0.f;
#pragma unroll
    for (int j = 0; j < 8; ++j) { const v4u w = *(const v4u*)(rp + (lane + 64 * j) * 8);
        v[8 * j] = bflo(w.x); v[8 * j + 1] = bfhi(w.x); v[8 * j + 2] = bflo(w.y); v[8 * j + 3] = bfhi(w.y); v[8 * j + 4] = bflo(w.z); v[8 * j + 5] = bfhi(w.z); v[8 * j + 6] = bflo(w.w); v[8 * j + 7] = bfhi(w.w); }
#pragma unroll
    for (int i = 0; i < 64; ++i) s += v[i];
    const float mean = wave_sum(s) * (1.f / 4096.f); float s2 = 0.f;
#pragma unroll
    for (int i = 0; i < 64; ++i) { v[i] -= mean; s2 += v[i] * v[i]; }
    const float rstd = 1.f / sqrtf(wave_sum(s2) * (1.f / 4096.f) + LN_EPS);
#pragma unroll
    for (int j = 0; j < 8; ++j) { const int c = (lane + 64 * j) * 8;
        const f32x4 g0 = *(const f32x4*)(g + c), g1 = *(const f32x4*)(g + c + 4), b0 = *(const f32x4*)(b + c), b1 = *(const f32x4*)(b + c + 4);
        f32x4 o0, o1;
#pragma unroll
        for (int i = 0; i < 4; ++i) { o0[i] = v[8 * j + i] * rstd * g0[i] + b0[i]; o1[i] = v[8 * j + 4 + i] * rstd * g1[i] + b1[i]; }
        *(f32x4*)(out + (size_t)row * 4096 + c) = o0; *(f32x4*)(out + (size_t)row * 4096 + c + 4) = o1; }
}
constexpr int NPH = 12;

struct Args { const float* in[29]; float* out; unsigned char* ws; int ph_lo, ph_hi; };
constexpr size_t O_Y = 0, O_STP = 35651584, O_CVP = 37748736, O_STS = 37822464, O_CVS = 104931328, O_VS = 107290624, O_END = 108339200;

__global__ void __launch_bounds__(NTHR, 2) mk_fwd(Args args) {
    extern __shared__ __attribute__((aligned(16))) unsigned char lds_raw[];
    LAS unsigned char* lds = (LAS unsigned char*)lds_raw;
    volatile LAS unsigned* MISC = (volatile LAS unsigned*)(lds + MISC_OFF);
    const int tid = threadIdx.x, lane = tid & 63, wave = __builtin_amdgcn_readfirstlane(tid >> 6);
    const int G = gridDim.x, bx = blockIdx.x, gw = bx * NWAVES + wave, NGW = G * NWAVES;
    unsigned char* ws = args.ws;
    unsigned* ctl = (unsigned*)(ws + WS_CTL);
    const int lo = args.ph_lo, hi = args.ph_hi;
    for (int u = tid; u < (LDS_BYTES - RING_BYTES) / 4; u += NTHR) ((LAS unsigned*)(lds + RING_BYTES))[u] = 0u;
    __syncthreads();
    XcdBarrier bar; bar.bar = ctl + CW_BAR; bar.x = 0; bar.st = nullptr;
    if (hi - lo > 1) bar = xcd_barrier_post(ctl + CW_BAR, MISC + 8);
#ifndef PH_MASK
#define PH_MASK 0xFFF
#endif
#define IN(k) (((PH_MASK >> (k)) & 1) && lo <= (k) && (k) < hi)
#define SEAM(k) do { if (IN(k) && IN((k) + 1)) xcd_barrier(bar); } while (0)

    bf16* Wt_in = (bf16*)(ws + WS_WIN); bf16* Wt_p = (bf16*)(ws + WS_WP); bf16* Wt_out = (bf16*)(ws + WS_WOUT); bf16* Wt_gu = (bf16*)(ws + WS_WGU); bf16* Wt_dn = (bf16*)(ws + WS_WDN);
    bf16* xb = (bf16*)(ws + WS_XB); bf16* H = (bf16*)(ws + WS_H); float* dtb = (float*)(ws + WS_DT); bf16* yraw = (bf16*)(ws + WS_YRAW); bf16* ycat = (bf16*)(ws + WS_YCAT);
    bf16* mrg = (bf16*)(ws + WS_MRG); bf16* r1b = (bf16*)(ws + WS_R1); bf16* xbcc = (bf16*)(ws + WS_R1); bf16* r2b = (bf16*)(ws + WS_YRAW); bf16* x1lo = (bf16*)(ws + WS_YRAW);
    unsigned char* xg = ws + WS_XG; unsigned char* Hm = ws + WS_HM;
    int* t_grp = (int*)(ws + WS_SMALL + SM_GRP); int* t_rank = (int*)(ws + WS_SMALL + SM_RANK); float* t_gw = (float*)(ws + WS_SMALL + SM_GW);
    int* t_tok = (int*)(ws + WS_SMALL + SM_TOK); float* t_gws = (float*)(ws + WS_SMALL + SM_GWS);
    unsigned* cnt = ctl + CW_CNT;
    float* out = args.out;

    const bool tailconv = (G == 256);
    constexpr int MOE_ITEMS = 3 * 32 * 512, MOE_SPLIT = 30720;
    if (IN(0)) {
        P0Args a{args.in[4], args.in[15], args.in[16], args.in[17], args.in[24], args.in[25], args.in[26], args.in[0], args.in[1], Wt_in, Wt_p, Wt_out, Wt_gu, Wt_dn, xb, args.in[20], args.in[22], (v4u*)(ws + WS_WRF), ws + WS_X8, ws + WS_W8, ws + WS_SB8, ws + WS_SA8, ws + WS_WGU, ws + WS_WDN, ws + WS_SBGU, ws + WS_SBDN, ws + WS_WOUT, ws + WS_WOUT + 16 * MiB, ws + WS_WP, ws + WS_WP + 24 * MiB};
        for (int rep = 0; rep < REP_P0; ++rep) p0_convert(a, lds, gw, NGW, wave, lane, !tailconv);
    }
    SEAM(0);
    if (IN(1)) {
        pg8::EpiIn E{H, dtb, args.in[7], (unsigned char*)(ws + WS_G8)};
        { pg8::Gemm g{xb, Wt_in, T, 22784, 4096}; pg8::SelOrder S; S.init(T, G, bx, 0);
          pg8::gemm_phase<pg8::EpiIn, pg8::SelOrder, true, true, 0>(lds, g, S, E); }
        { pg8::Gemm g{(const bf16*)(ws + WS_X8), (const bf16*)(ws + WS_W8), T, 22784, 2048, (const unsigned*)(ws + WS_SA8), (const unsigned*)(ws + WS_SB8)}; pg8::SelOrder S; S.init(T, G, (bx + 144) % G, 1);
          pg8::gemm_phase<pg8::EpiIn, pg8::SelOrder, true, true, 1>(lds, g, S, E); }
    }
    SEAM(1);
    if (IN(2)) for (int rep = 0; rep < REP_P2; ++rep) p2_conv(H, args.in[3], args.in[5], args.in[6], xbcc, out + O_CVP, out + O_CVS, (size_t)bx * NTHR + tid, (size_t)G * NTHR);
    SEAM(2);
    if (IN(3)) {
        { const int u = bx, b = u >> 6, h = u & 63;
          const SmpArgs sm{args.in[2], out + O_STS, args.in[8], args.in[9], bx, 1};
          ssd_chunk_unit(xbcc, dtb, b, h, -__expf(args.in[8][h]), args.in[9][h], yraw, out + O_STP + (size_t)u * 8192, lds, tid, sm); }
        for (int row = gw; row < T; row += NGW) vln_row(H, args.in[11], args.in[12], out + O_VS, row, lane);
    }
    SEAM(3);
    if (IN(4)) {
        for (int rep = 0; rep < REP_P4; ++rep) {
        unsigned char* ycat8 = ws + WS_YCAT; unsigned char* say = ws + WS_YCAT + 60 * MiB;
        for (int row = gw; row < T; row += NGW) ssdnorm_row(yraw, H, args.in[10], ycat8, say, row, lane);
        for (int u = bx; u < 512; u += G) sgu_unit(H, args.in[13], args.in[14], ycat8, say, (u >> 3) * 128, u & 7, lds, tid);
        for (int it = gw; it < (T - TP) * 4; it += NGW) sgu_item(H, args.in[13], args.in[14], ycat8, say, TP + (it >> 2), it & 3, lane); }
    }
    SEAM(4);
    if (IN(5)) {
        pg8::Gemm g{(const bf16*)(ws + WS_YCAT), (const bf16*)(ws + WS_WP), T, 4096, 3072, (const unsigned*)(ws + WS_YCAT + 60 * MiB), (const unsigned*)(ws + WS_WP + 24 * MiB)}; pg8::StaticOrder S; S.init(T, 4096, G, bx);
        pg8::EpiMerge E{(const unsigned char*)(ws + WS_G8), ws + WS_MRG, 32, (LAS float*)(lds + RING_BYTES), (unsigned*)(ws + WS_MRG + 40 * MiB)};
        pg8::gemm_phase<pg8::EpiMerge, pg8::StaticOrder, true, true, 3>(lds, g, S, E);
        if (tailconv && bx >= 32) { P0Args a{args.in[4], args.in[15], args.in[16], args.in[17], args.in[24], args.in[25], args.in[26], args.in[0], args.in[1], Wt_in, Wt_p, Wt_out, Wt_gu, Wt_dn, xb, args.in[20], args.in[22], (v4u*)(ws + WS_WRF), nullptr, nullptr, nullptr, nullptr, ws + WS_WGU, ws + WS_WDN, ws + WS_SBGU, ws + WS_SBDN, ws + WS_WOUT, ws + WS_WOUT + 16 * MiB, ws + WS_WP, ws + WS_WP + 24 * MiB};
            conv_wout(a, lds, (bx - 32) * NWAVES + wave, 224 * NWAVES, wave, lane);
            conv_moe(a, lds, 0, MOE_SPLIT, (bx - 32) * NWAVES + wave, 224 * NWAVES, wave, lane); }
    }
    SEAM(5);
    if (IN(6)) {
        pg8::Gemm g{(const bf16*)(ws + WS_MRG), (const bf16*)(ws + WS_WOUT), T, 4096, 2048, (const unsigned*)(ws + WS_MRG + 40 * MiB), (const unsigned*)(ws + WS_WOUT + 16 * MiB)}; pg8::StaticOrder S; S.init(T, 4096, G, bx);
        pg8::EpiRes E{xb, r1b};
        pg8::gemm_phase<pg8::EpiRes, pg8::StaticOrder, true, true, 3>(lds, g, S, E);
        if (tailconv && bx >= 32) { P0Args a{args.in[4], args.in[15], args.in[16], args.in[17], args.in[24], args.in[25], args.in[26], args.in[0], args.in[1], Wt_in, Wt_p, Wt_out, Wt_gu, Wt_dn, xb, args.in[20], args.in[22], (v4u*)(ws + WS_WRF), nullptr, nullptr, nullptr, nullptr, ws + WS_WGU, ws + WS_WDN, ws + WS_SBGU, ws + WS_SBDN, ws + WS_WOUT, ws + WS_WOUT + 16 * MiB, ws + WS_WP, ws + WS_WP + 24 * MiB};
            conv_moe(a, lds, MOE_SPLIT, MOE_ITEMS, (bx - 32) * NWAVES + wave, 224 * NWAVES, wave, lane); }
    }
    SEAM(6);
    if (IN(7)) {
        P7Args a{r1b, x1lo, xb, args.in[18], args.in[19], args.in[21], args.in[23], (const v4u*)(ws + WS_WRF), cnt, t_grp, t_rank, t_gw};
        for (int blk = bx; blk < 256; blk += G) {
            const int rb0 = blk * 34;
            for (int r = wave; r < 34; r += NWAVES) ln1_row(a, rb0 + r, lane);
            __syncthreads();
            if (wave < 3) router_tile(a, rb0 + 16 * wave, wave < 2 ? 16 : 2, (LAS float*)(lds + wave * 4096), lane);
            __syncthreads();
        }
    }
    SEAM(7);
    if (IN(8)) p8_sort(xb, cnt, t_grp, t_rank, t_gw, xg, ws + WS_SAXG, t_tok, t_gws, gw, NGW, lane);
    SEAM(8);
    if (IN(9)) {
        pg8::Gemm g{(const bf16*)xg, (const bf16*)(ws + WS_WGU), XG_ROWS, 8 * 4096, 2048, (const unsigned*)(ws + WS_SAXG), (const unsigned*)(ws + WS_SBGU)}; pg8::MoeOrderT<1> S; S.init(cnt, G, bx, ctl + CW_RDY);
        pg8::EpiGU E{t_gws, Hm};
        for (int rep = 0; rep < REP_P9; ++rep) pg8::gemm_phase<pg8::EpiGU, pg8::MoeOrderT<1>, true, true, 1>(lds, g, S, E);
    }
    if (IN(10)) {
        pg8::Gemm g{(const bf16*)Hm, (const bf16*)(ws + WS_WDN), XG_ROWS, 8 * 4096, 1024, nullptr, (const unsigned*)(ws + WS_SBDN)}; pg8::MoeOrderT<2> S; S.init(cnt, G, bx, ctl + CW_RDY);
        pg8::EpiDown E{t_tok, xb, r2b};
        for (int rep = 0; rep < REP_P10; ++rep) pg8::gemm_phase<pg8::EpiDown, pg8::MoeOrderT<2>, true, true, 2>(lds, g, S, E);
    }
    SEAM(10);
    if (IN(11)) for (int rep = 0; rep < REP_P11; ++rep) { for (int row = gw; row < T; row += NGW) ln2_row(r2b, args.in[27], args.in[28], out + O_Y, row, lane); }
#undef IN
#undef SEAM
}

#ifndef MK_ONE_LAUNCH
#define MK_ONE_LAUNCH 1
#endif
extern "C" void kernel_launch(void* const* d_in, const int* in_sizes, int n_in, void* d_out, int out_size, void* d_ws, size_t ws_size, hipStream_t stream) {
    static int grid = 0;
    if (grid == 0) {
        if (n_in != 29 || (size_t)out_size != O_END || ws_size < WS_END) { fprintf(stderr, "kernel_launch: unexpected shapes (n_in %d out %d ws %zu need %zu); nothing launched\n", n_in, out_size, ws_size, (size_t)WS_END); grid = -1; return; }
        int dev = 0, cus = 0, per_cu = 0;
        if (hipGetDevice(&dev) != hipSuccess || hipDeviceGetAttribute(&cus, hipDeviceAttributeMultiprocessorCount, dev) != hipSuccess) { grid = -1; return; }
        if (hipFuncSetAttribute((const void*)mk_fwd, hipFuncAttributeMaxDynamicSharedMemorySize, LDS_BYTES) != hipSuccess) { fprintf(stderr, "kernel_launch: hipFuncSetAttribute failed\n"); grid = -1; return; }
        if (hipOccupancyMaxActiveBlocksPerMultiprocessor(&per_cu, (const void*)mk_fwd, NTHR, LDS_BYTES) != hipSuccess || per_cu < 1) { fprintf(stderr, "kernel_launch: occupancy query says %d\n", per_cu); }
        (void)hipGetLastError();
        grid = cus;
        if (grid != 256) { fprintf(stderr, "kernel_launch: built for a 256-CU device (got %d CUs); nothing launched\n", cus); grid = -1; return; }
    }
    if (grid < 0) return;
    if (hipMemsetAsync((char*)d_ws + WS_CTL, 0, CTL_ZERO_BYTES, stream) != hipSuccess) return;
    Args a{};
    for (int i = 0; i < 29; ++i) a.in[i] = (const float*)d_in[i];
    a.out = (float*)d_out; a.ws = (unsigned char*)d_ws;
#if MK_ONE_LAUNCH
    a.ph_lo = 0; a.ph_hi = NPH;
    hipLaunchKernelGGL(mk_fwd, dim3(grid), dim3(NTHR), LDS_BYTES, stream, a);
#else
    for (int k = 0; k < NPH; ++k) { a.ph_lo = k; a.ph_hi = k + 1; hipLaunchKernelGGL(mk_fwd, dim3(grid), dim3(NTHR), LDS_BYTES, stream, a); }
#endif
}
```
